# Optimizing an MI355X kernel written in HIP

```python
import math
import jax, jax.numpy as jnp
from jax import lax
import numpy as np

D_MODEL = 1024
BATCH = 2
SEQ = 8192
DEPTH = 1

CHUNK = 64
NORM_EPS = 1e-6
GDN_HEADS = 8
GDN_DK = 128
GDN_DV = 128
GDN_CONV = 4
MLA_HEADS = 8
MLA_Q_LORA = 512
MLA_KV_LORA = 256
MLA_NOPE = 128
MLA_ROPE = 64
MLA_V = 128
ROPE_THETA = 10000.0
Q_BLOCK = 128
N_EXPERTS = 32
TOP_K = 4
D_EXPERT = 1024
SWIGLU_LIMIT = 7.0
SWIGLU_ALPHA = 1.702
MOE_BLOCK = 128

GDN_QK_W = GDN_HEADS * GDN_DK
GDN_V_W = GDN_HEADS * GDN_DV
GDN_CONV_W = 2 * GDN_QK_W + GDN_V_W
COL_SIZES = (GDN_QK_W, GDN_QK_W, GDN_V_W, GDN_V_W, GDN_HEADS, GDN_HEADS,
             MLA_Q_LORA, MLA_KV_LORA + MLA_ROPE, D_MODEL, D_MODEL)
IN_COLS = sum(COL_SIZES)
COL_SPLITS = tuple(int(c) for c in np.cumsum(COL_SIZES)[:-1])

kernel_name = 'hybrid_gdn_mla_moe_block'


def rmsnorm(x, w):
    xf = x.astype(jnp.float32)
    xf = xf * lax.rsqrt(jnp.mean(xf * xf, axis=-1, keepdims=True) + NORM_EPS)
    return (xf * w.astype(jnp.float32)).astype(x.dtype)


def l2norm(x):
    xf = x.astype(jnp.float32)
    return xf * lax.rsqrt(jnp.sum(xf * xf, axis=-1, keepdims=True) + NORM_EPS)


def causal_depthwise_conv(x, w):
    k_taps, c = w.shape
    return lax.conv_general_dilated(
        x, w[:, None, :].astype(x.dtype), window_strides=(1,),
        padding=[(k_taps - 1, 0)], dimension_numbers=('NWC', 'WIO', 'NWC'),
        feature_group_count=c)


def to_chunks(t):
    b, s, h = t.shape[:3]
    t = t.reshape((b, s // CHUNK, CHUNK, h) + t.shape[3:])
    return jnp.moveaxis(t, 3, 1)


def gated_delta_rule(q, k, v, g, beta):
    b, s, h, dk = q.shape
    dv = v.shape[-1]
    qc, kc, vc = to_chunks(q), to_chunks(k), to_chunks(v)
    gc = jnp.cumsum(to_chunks(g), axis=-1)
    bc = to_chunks(beta)[..., None]
    idx = jnp.arange(CHUNK)
    incl = idx[:, None] >= idx[None, :]
    strict = idx[:, None] > idx[None, :]
    decay = jnp.exp(jnp.where(incl, gc[..., :, None] - gc[..., None, :], -jnp.inf))
    kb = kc * bc
    lower = jnp.where(strict, jnp.einsum('bhnck,bhnmk->bhncm', kb, kc) * decay, 0.0)
    a_mat = jnp.eye(CHUNK, dtype=jnp.float32) + lower
    u = lax.linalg.triangular_solve(a_mat, vc * bc, left_side=True, lower=True)
    w = lax.linalg.triangular_solve(a_mat, kb * jnp.exp(gc)[..., None], left_side=True, lower=True)
    qk = jnp.where(incl, jnp.einsum('bhnck,bhnmk->bhncm', qc, kc) * decay, 0.0)
    q_dec = qc * jnp.exp(gc)[..., None]
    k_dec = kc * jnp.exp(gc[..., -1:] - gc)[..., None]
    g_last = jnp.exp(gc[..., -1])

    def step(state, inp):
        u_i, w_i, qk_i, qd_i, kd_i, gl_i = inp
        v_new = u_i - jnp.einsum('bhck,bhkv->bhcv', w_i, state)
        o_i = jnp.einsum('bhck,bhkv->bhcv', qd_i, state) + jnp.einsum('bhcm,bhmv->bhcv', qk_i, v_new)
        state = state * gl_i[..., None, None] + jnp.einsum('bhck,bhcv->bhkv', kd_i, v_new)
        return state, o_i

    xs = tuple(jnp.moveaxis(t, 2, 0) for t in (u, w, qk, q_dec, k_dec, g_last))
    state0 = jnp.zeros((b, h, dk, dv), jnp.float32)
    _, o = lax.scan(step, state0, xs)
    return jnp.transpose(o, (1, 0, 3, 2, 4)).reshape(b, s, h, dv)


def rope_tables(s):
    inv = 1.0 / (ROPE_THETA ** (jnp.arange(0, MLA_ROPE, 2, dtype=jnp.float32) / MLA_ROPE))
    ang = jnp.arange(s, dtype=jnp.float32)[:, None] * inv[None, :]
    ang = jnp.concatenate([ang, ang], axis=-1)
    return jnp.cos(ang), jnp.sin(ang)


def apply_rope(x, cos, sin):
    shape = (x.shape[1],) + (1,) * (x.ndim - 3) + (x.shape[-1],)
    xf = x.astype(jnp.float32)
    half = x.shape[-1] // 2
    rot = jnp.concatenate([-xf[..., half:], xf[..., :half]], axis=-1)
    return (xf * cos.reshape(shape) + rot * sin.reshape(shape)).astype(x.dtype)


def chunk_causal_attention(q, k, v):
    b, s, h, dqk = q.shape
    n_blocks = s // Q_BLOCK
    scale = dqk ** -0.5
    k_chunk = jnp.arange(s) // CHUNK

    def one_block(i):
        start = i * Q_BLOCK
        qb = lax.dynamic_slice_in_dim(q, start, Q_BLOCK, axis=1)
        sc = jnp.einsum('bqhd,bkhd->bhqk', qb, k, preferred_element_type=jnp.float32) * scale
        q_chunk = (start + jnp.arange(Q_BLOCK)) // CHUNK
        mask = k_chunk[None, :] <= q_chunk[:, None]
        p = jax.nn.softmax(jnp.where(mask, sc, -jnp.inf), axis=-1).astype(v.dtype)
        return jnp.einsum('bhqk,bkhd->bqhd', p, v)

    o = lax.map(one_block, jnp.arange(n_blocks))
    return jnp.moveaxis(o, 0, 1).reshape(b, s, h, v.shape[-1])


def hybrid_mixer(h, cos, sin, w_in, gdn_conv_w, gdn_a_log, gdn_dt_bias, gdn_norm_w, w_gdn_o,
                 mla_q_norm_w, w_mla_q_b, mla_kv_norm_w, w_mla_kv_b, w_mla_o, w_out):
    b, s, _ = h.shape
    f32 = jnp.float32
    proj = jnp.einsum('bsd,de->bse', h, w_in)
    q_g, k_g, v_g, z_g, b_g, a_g, c_q, c_kv, gate_a, gate_b = jnp.split(proj, COL_SPLITS, axis=-1)

    qkv = jax.nn.silu(causal_depthwise_conv(jnp.concatenate([q_g, k_g, v_g], axis=-1), gdn_conv_w))
    q_g, k_g, v_g = jnp.split(qkv, (GDN_QK_W, 2 * GDN_QK_W), axis=-1)
    q_g = l2norm(q_g.reshape(b, s, GDN_HEADS, GDN_DK)) * (GDN_DK ** -0.5)
    k_g = l2norm(k_g.reshape(b, s, GDN_HEADS, GDN_DK))
    v_g = v_g.reshape(b, s, GDN_HEADS, GDN_DV).astype(f32)
    beta = jax.nn.sigmoid(b_g.astype(f32))
    g = -jnp.exp(gdn_a_log.astype(f32)) * jax.nn.softplus(a_g.astype(f32) + gdn_dt_bias.astype(f32))
    o_a = gated_delta_rule(q_g, k_g, v_g, g, beta)
    o_a = rmsnorm(o_a, gdn_norm_w) * jax.nn.silu(z_g.reshape(b, s, GDN_HEADS, GDN_DV).astype(f32))
    y_a = jnp.einsum('bse,ed->bsd', o_a.reshape(b, s, GDN_V_W).astype(h.dtype), w_gdn_o)

    q = jnp.einsum('bsr,re->bse', rmsnorm(c_q, mla_q_norm_w), w_mla_q_b)
    q = q.reshape(b, s, MLA_HEADS, MLA_NOPE + MLA_ROPE)
    q_nope, q_rope = q[..., :MLA_NOPE], apply_rope(q[..., MLA_NOPE:], cos, sin)
    kv_lat = rmsnorm(c_kv[..., :MLA_KV_LORA], mla_kv_norm_w)
    k_rope = apply_rope(c_kv[..., MLA_KV_LORA:], cos, sin)
    kv = jnp.einsum('bsr,re->bse', kv_lat, w_mla_kv_b).reshape(b, s, MLA_HEADS, MLA_NOPE + MLA_V)
    k_nope, v = kv[..., :MLA_NOPE], kv[..., MLA_NOPE:]
    q_full = jnp.concatenate([q_nope, q_rope], axis=-1)
    k_full = jnp.concatenate([k_nope, jnp.broadcast_to(k_rope[:, :, None, :], (b, s, MLA_HEADS, MLA_ROPE))], axis=-1)
    o_b = chunk_causal_attention(q_full, k_full, v)
    y_b = jnp.einsum('bse,ed->bsd', o_b.reshape(b, s, MLA_HEADS * MLA_V), w_mla_o)

    merged = jax.nn.sigmoid(gate_a) * y_a + jax.nn.sigmoid(gate_b) * y_b
    return jnp.einsum('bsd,de->bse', merged, w_out)


def moe_ffn(h, w_router, b_router, w_gate_up, b_gate_up, w_down, b_down):
    b, s, d = h.shape
    f32 = jnp.float32
    n_tok = b * s
    hf = h.reshape(n_tok, d)
    logits = (hf @ w_router).astype(f32) + b_router.astype(f32)
    top_logits, top_idx = lax.top_k(logits, TOP_K)
    top_w = jax.nn.softmax(top_logits, axis=-1)
    n_assign = n_tok * TOP_K
    flat_e = top_idx.reshape(-1)
    order = jnp.argsort(flat_e)
    sorted_e = flat_e[order]
    counts = jnp.bincount(flat_e, length=N_EXPERTS)
    start = jnp.cumsum(counts) - counts
    padded = (counts + MOE_BLOCK - 1) // MOE_BLOCK * MOE_BLOCK
    pad_end = jnp.cumsum(padded)
    pad_start = pad_end - padded
    dest = pad_start[sorted_e] + jnp.arange(n_assign) - start[sorted_e]
    n_pad = n_assign + N_EXPERTS * MOE_BLOCK
    n_blocks = n_pad // MOE_BLOCK
    slot_tok = jnp.zeros((n_pad,), jnp.int32).at[dest].set((order // TOP_K).astype(jnp.int32))
    slot_w = jnp.zeros((n_pad,), f32).at[dest].set(top_w.reshape(-1)[order])
    block_e = jnp.minimum(jnp.searchsorted(pad_end, jnp.arange(n_blocks) * MOE_BLOCK, side='right'), N_EXPERTS - 1)
    xs = hf[slot_tok].reshape(n_blocks, MOE_BLOCK, d)

    def expert_block(args):
        xb, e = args
        gu = xb @ w_gate_up[e] + b_gate_up[e]
        gate = jnp.minimum(gu[:, ::2], SWIGLU_LIMIT)
        up = jnp.clip(gu[:, 1::2], -SWIGLU_LIMIT, SWIGLU_LIMIT)
        act = (up + 1.0) * (gate * jax.nn.sigmoid(gate * SWIGLU_ALPHA))
        return act @ w_down[e] + b_down[e]

    ys = lax.map(expert_block, (xs, block_e)).reshape(n_pad, d)
    y = jax.ops.segment_sum(ys.astype(f32) * slot_w[:, None], slot_tok, num_segments=n_tok)
    return y.astype(h.dtype).reshape(b, s, d)


def setup_inputs(seed: int = 0) -> dict:
    key = jax.random.key(seed)
    ks = iter(jax.random.split(key, 24))
    f32 = jnp.float32

    def nrm(shape, scale):
        return jax.random.normal(next(ks), shape, f32) * scale

    L = DEPTH
    x = nrm((BATCH, SEQ, D_MODEL), 1.0)
    norm_mix_w = 1.0 + nrm((L, D_MODEL), 0.05)
    w_in = nrm((L, D_MODEL, IN_COLS), D_MODEL ** -0.5)
    gdn_conv_w = nrm((L, GDN_CONV, GDN_CONV_W), GDN_CONV ** -0.5)
    gdn_a_log = jnp.log(jax.random.uniform(next(ks), (L, GDN_HEADS), f32, 1.0, 16.0))
    dt = jnp.exp(jax.random.uniform(next(ks), (L, GDN_HEADS), f32, math.log(1e-3), math.log(1e-1)))
    gdn_dt_bias = dt + jnp.log(-jnp.expm1(-dt))
    gdn_norm_w = 1.0 + nrm((L, GDN_DV), 0.05)
    w_gdn_o = nrm((L, GDN_V_W, D_MODEL), GDN_V_W ** -0.5)
    mla_q_norm_w = 1.0 + nrm((L, MLA_Q_LORA), 0.05)
    w_mla_q_b = nrm((L, MLA_Q_LORA, MLA_HEADS * (MLA_NOPE + MLA_ROPE)), MLA_Q_LORA ** -0.5)
    mla_kv_norm_w = 1.0 + nrm((L, MLA_KV_LORA), 0.05)
    w_mla_kv_b = nrm((L, MLA_KV_LORA, MLA_HEADS * (MLA_NOPE + MLA_V)), MLA_KV_LORA ** -0.5)
    w_mla_o = nrm((L, MLA_HEADS * MLA_V, D_MODEL), (MLA_HEADS * MLA_V) ** -0.5)
    w_out = nrm((L, D_MODEL, D_MODEL), D_MODEL ** -0.5)
    norm_ffn_w = 1.0 + nrm((L, D_MODEL), 0.05)
    w_router = nrm((L, D_MODEL, N_EXPERTS), D_MODEL ** -0.5)
    b_router = nrm((L, N_EXPERTS), 0.01)
    w_gate_up = nrm((L, N_EXPERTS, D_MODEL, 2 * D_EXPERT), D_MODEL ** -0.5)
    b_gate_up = nrm((L, N_EXPERTS, 2 * D_EXPERT), 0.01)
    w_down = nrm((L, N_EXPERTS, D_EXPERT, D_MODEL), D_EXPERT ** -0.5)
    b_down = nrm((L, N_EXPERTS, D_MODEL), 0.01)
    norm_final_w = 1.0 + nrm((D_MODEL,), 0.05)
    return {'x': x, 'norm_mix_w': norm_mix_w, 'w_in': w_in, 'gdn_conv_w': gdn_conv_w,
            'gdn_a_log': gdn_a_log, 'gdn_dt_bias': gdn_dt_bias, 'gdn_norm_w': gdn_norm_w,
            'w_gdn_o': w_gdn_o, 'mla_q_norm_w': mla_q_norm_w, 'w_mla_q_b': w_mla_q_b,
            'mla_kv_norm_w': mla_kv_norm_w, 'w_mla_kv_b': w_mla_kv_b, 'w_mla_o': w_mla_o,
            'w_out': w_out, 'norm_ffn_w': norm_ffn_w, 'w_router': w_router, 'b_router': b_router,
            'w_gate_up': w_gate_up, 'b_gate_up': b_gate_up, 'w_down': w_down, 'b_down': b_down,
            'norm_final_w': norm_final_w}


def reference(x, norm_mix_w, w_in, gdn_conv_w, gdn_a_log, gdn_dt_bias, gdn_norm_w, w_gdn_o,
              mla_q_norm_w, w_mla_q_b, mla_kv_norm_w, w_mla_kv_b, w_mla_o, w_out,
              norm_ffn_w, w_router, b_router, w_gate_up, b_gate_up, w_down, b_down, norm_final_w):
    cos, sin = rope_tables(x.shape[1])
    for layer in range(DEPTH):
        h = rmsnorm(x, norm_mix_w[layer])
        x = x + hybrid_mixer(h, cos, sin, w_in[layer], gdn_conv_w[layer], gdn_a_log[layer],
                             gdn_dt_bias[layer], gdn_norm_w[layer], w_gdn_o[layer],
                             mla_q_norm_w[layer], w_mla_q_b[layer], mla_kv_norm_w[layer],
                             w_mla_kv_b[layer], w_mla_o[layer], w_out[layer])
        h = rmsnorm(x, norm_ffn_w[layer])
        x = x + moe_ffn(h, w_router[layer], b_router[layer], w_gate_up[layer], b_gate_up[layer],
                        w_down[layer], b_down[layer])
    return rmsnorm(x, norm_final_w)
```

```cpp
#include <hip/hip_runtime.h>
#include <hip/hip_cooperative_groups.h>
#include <cstdio>
#include <cstdint>
namespace cg = cooperative_groups;

#define DI __device__ __forceinline__
#define LAS __attribute__((address_space(3)))
typedef unsigned short bf16_t;
typedef short bf16x8 __attribute__((ext_vector_type(8)));
typedef short s16x4 __attribute__((ext_vector_type(4)));
typedef float f32x2 __attribute__((ext_vector_type(2)));
typedef float f32x4 __attribute__((ext_vector_type(4)));
typedef float f32x16 __attribute__((ext_vector_type(16)));
typedef unsigned u32x2 __attribute__((ext_vector_type(2)));
typedef unsigned u32x4 __attribute__((ext_vector_type(4)));
typedef int i32x4 __attribute__((ext_vector_type(4)));
typedef __bf16 bf16x2_t __attribute__((ext_vector_type(2)));

constexpr int T_TOK = 16384, SEQ = 8192, DM = 1024;
constexpr int NP = 7168;
constexpr int C_Q = 0, C_K = 1024, C_V = 2048, C_Z = 3072, C_GA = 4096, C_GB = 5120, C_CQ = 6144, C_CKV = 6656, C_KR = 6912, C_BG = 6976, C_AG = 6984;
constexpr int NEXP = 32;
constexpr float EPS = 1e-6f;
constexpr float QSCALE = 0.10411754627697264f;

constexpr size_t MiB = 1u << 20;
constexpr size_t WS_CTL = 0, CTL_BYTES = 32768;
constexpr size_t WS_WIN = 2 * MiB, WS_WGDNO = 16 * MiB, WS_WMLAO = 18 * MiB, WS_WOUT = 20 * MiB, WS_WQB = 22 * MiB, WS_WKVB = 24 * MiB, WS_ROPE = 26 * MiB;
constexpr size_t WS_SSQQ = 28 * MiB, WS_SSQKV = 28 * MiB + 512 * 1024, WS_GLAST = 29 * MiB, WS_TOPI = 29 * MiB + 512 * 1024, WS_TOPW = 30 * MiB, WS_TOKSLOT = 30 * MiB + 512 * 1024,
                 WS_CNT = 31 * MiB, WS_TILEE = 31 * MiB + 256 * 1024, WS_SLOTTOK = 31 * MiB + 512 * 1024;
constexpr size_t WS_WGU = 32 * MiB, WS_WD = 160 * MiB, WS_XN = 224 * MiB, WS_PROJ = 256 * MiB, WS_FR = 480 * MiB, WS_Q = 624 * MiB, WS_K = 672 * MiB, WS_V = 720 * MiB,
                 WS_OA = 752 * MiB, WS_OB = 784 * MiB, WS_AA = 816 * MiB, WS_MG = 848 * MiB, WS_X1 = 880 * MiB, WS_END = 944 * MiB;
constexpr size_t WS_H2 = WS_XN, WS_ACT = WS_PROJ, WS_YS = WS_Q;
constexpr int FR_UNIT = 73728, FR_NW = 0, FR_QD = 16384, FR_KD = 32768, FR_QK = 49152, FR_U = 57344;
constexpr int LDS_BYTES = 163840;

DI unsigned pk2(float lo, float hi) { f32x2 v = {lo, hi}; bf16x2_t b = __builtin_convertvector(v, bf16x2_t); return __builtin_bit_cast(unsigned, b); }
DI bf16_t f2bf(float f) { return (bf16_t)(pk2(f, 0.f) & 0xffffu); }
DI float bf2f(bf16_t b) { return __uint_as_float((unsigned)b << 16); }
DI float bflo(unsigned w) { return __uint_as_float(w << 16); }
DI float bfhi(unsigned w) { return __uint_as_float(w & 0xffff0000u); }
DI int threadIdx_x_raw() { return (int)__builtin_amdgcn_workitem_id_x(); }
DI float sigmoidf_(float x) { return 1.f / (1.f + __expf(-x)); }
DI int tidx() { int t = threadIdx_x_raw(); asm volatile("" : "+v"(t)); return t; }
DI int crow(int r, int h) { return (r & 3) + 8 * (r >> 2) + 4 * h; }
DI float wave_sum(float v) {
#pragma unroll
    for (int o = 1; o < 64; o <<= 1) v += __shfl_xor(v, o);
    return v;
}
#define LDS_WAIT() asm volatile("s_waitcnt lgkmcnt(0)" ::: "memory")
#define MFMA32(a, b, c) __builtin_amdgcn_mfma_f32_32x32x16_bf16((a), (b), (c), 0, 0, 0)
DI bf16x8 pack8(float a0, float a1, float a2, float a3, float a4, float a5, float a6, float a7) {
    u32x4 p; p.x = pk2(a0, a1); p.y = pk2(a2, a3); p.z = pk2(a4, a5); p.w = pk2(a6, a7); return __builtin_bit_cast(bf16x8, p);
}
DI bf16x8 pack_step(const f32x16& x, int s) { return pack8(x[8 * s], x[8 * s + 1], x[8 * s + 2], x[8 * s + 3], x[8 * s + 4], x[8 * s + 5], x[8 * s + 6], x[8 * s + 7]); }

namespace pg8 {
constexpr int BM = 256, BK = 64, HALF = 128, HTB = HALF * BK * 2, STAGE_BYTES = 8 * HTB, NXCD = 8, WGM = 8;
__host__ __device__ __forceinline__ int lds_byte(int r, int c) { const int st = (r >> 4) * 2 + (c >> 5), rr = r & 15, cc = c & 31, ob = rr * 64 + cc * 2; return st * 1024 + (ob ^ (((ob >> 9) & 1) << 5)); }
__host__ __device__ __forceinline__ void stage_rc(int b, int& R, int& C) { const int st = b / 1024, sb = b % 1024, swz = sb ^ (((sb >> 9) & 1) << 5); R = (st >> 1) * 16 + swz / 64; C = (st & 1) * 32 + (swz % 64) / 2; }
__host__ __device__ __forceinline__ int perm32(int rho) { const int n = rho >> 4, i = rho & 15; return 8 * (i >> 2) + 4 * n + (i & 3); }

struct Unit { const char* A; const char* B; int pm, pn, aux; };
template <class S, class = void> struct sched_var_k { static constexpr bool value = false; };
template <class S> struct sched_var_k<S, decltype((void)S::VAR_K)> { static constexpr bool value = S::VAR_K; };
template <class E, class = void> struct epi_chain { static constexpr bool value = false; };
template <class E> struct epi_chain<E, decltype((void)E::CHAIN)> { static constexpr bool value = E::CHAIN; };

DI bool tile_of(int i, int G, int c, int nM, int nN, int& pm, int& pn) {
    const int nwg = nM * nN; const long L = (long)i * G + c; if (L >= nwg) return false;
    int wgid = (int)L; { const int q = nwg / NXCD, r = nwg % NXCD, xcd = wgid % NXCD, off = wgid / NXCD; wgid = (xcd < r ? xcd * (q + 1) : r * (q + 1) + (xcd - r) * q) + off; }
    const int nig = WGM * nN, gid = wgid / nig, fm = gid * WGM, gsz = (nM - fm) < WGM ? (nM - fm) : WGM;
    pm = fm + ((wgid % nig) % gsz); pn = (wgid % nig) / gsz; return true;
}
DI void tile_from_L(int L, int nM, int nN, int& pm, int& pn) {
    const int nwg = nM * nN; int wgid = L; { const int q = nwg / NXCD, r = nwg % NXCD, xcd = wgid % NXCD, off = wgid / NXCD; wgid = (xcd < r ? xcd * (q + 1) : r * (q + 1) + (xcd - r) * q) + off; }
    const int nig = WGM * nN, gid = wgid / nig, fm = gid * WGM, gsz = (nM - fm) < WGM ? (nM - fm) : WGM;
    pm = fm + ((wgid % nig) % gsz); pn = (wgid % nig) / gsz;
}
struct DenseSched {
    const char* A; const char* B; size_t atile, btile; int nM, nN, G, c;
    DI bool next(int i, Unit& u) const { int pm, pn; if (!tile_of(i, G, c, nM, nN, pm, pn)) return false; u.pm = pm; u.pn = pn; u.aux = 0; u.A = A + (size_t)pm * atile; u.B = B + (size_t)pn * btile; return true; }
};
struct PairSched {
    const char* A0; const char* B0; const char* A1; const char* B1; size_t atile, btile; int nM, nN, G, c;
    DI bool next(int i, Unit& u) const { int pm, pn; if (!tile_of(i >> 1, G, c, nM, nN, pm, pn)) return false; u.pm = pm; u.pn = pn; u.aux = i & 1;
        u.A = ((i & 1) ? A1 : A0) + (size_t)pm * atile; u.B = ((i & 1) ? B1 : B0) + (size_t)pn * btile; return true; }
};
struct QKVSched {
    static constexpr bool VAR_K = true;
    const char* Aq; const char* Bq; const char* Akv; const char* Bkv; int G, c;
    DI int nt_of(const Unit& u) const { return u.aux ? 4 : 8; }
    DI bool next(int i, Unit& u) const {
        int kind, idx;
        if (G == 256) {
            if (c < 128) { if (i > 2) return false; kind = (i == 2); idx = (i == 0) ? c : (i == 1) ? 256 + c : c; }
            else { if (i > 3) return false; kind = (i > 0); idx = (i == 0) ? c : 128 + 3 * (c - 128) + (i - 1); }
        } else { const int L = i * G + c; if (L >= 896) return false; kind = (L >= 384); idx = kind ? L - 384 : L; }
        int pm, pn; tile_from_L(idx, 64, kind ? 8 : 6, pm, pn);
        u.pm = pm; u.pn = pn; u.aux = kind;
        u.A = (kind ? Akv : Aq) + (size_t)pm * ((size_t)256 * NP * 2); u.B = (kind ? Bkv : Bq) + (size_t)pn * ((size_t)256 * 512 * 2);
        return true;
    }
};
struct MoeSched {
    const char* A; const char* B; size_t atile, btile, ebytes; LAS const int* ue; int nM, nN, G, c;
    DI bool next(int i, Unit& u) const { int pm, pn; if (!tile_of(i, G, c, nM, nN, pm, pn)) return false; u.pm = pm; u.pn = pn; const int e = __builtin_amdgcn_readfirstlane(ue[i]); u.aux = e;
        u.A = A + (size_t)pm * atile; u.B = B + (size_t)e * ebytes + (size_t)pn * btile; return true; }
};

typedef int v4i_t __attribute__((ext_vector_type(4)));
typedef int v8i_t __attribute__((ext_vector_type(8)));
DI v8i_t cat8(bf16x8 lo, bf16x8 hi) { const v4i_t a = __builtin_bit_cast(v4i_t, lo), b = __builtin_bit_cast(v4i_t, hi); return __builtin_shufflevector(a, b, 0, 1, 2, 3, 4, 5, 6, 7); }
constexpr int F8_WSHIFT = 6, F8_ASHIFT = 4, F8_CSHIFT = 2, F8_YSHIFT = 4;
constexpr float F8_UNSCALE = 1.f / (float)(1 << (F8_WSHIFT + F8_ASHIFT)), F8_UNSCALE_DOWN = 1.f / (float)(1 << (F8_WSHIFT + F8_CSHIFT));
template <class Epi, class Sched, bool GATHER = false, bool F8 = false>
DI void gemm_phase(LAS unsigned char* lds, const int lda, const int ldb, const int K, const Sched& S, const Epi& E, LAS const int* tokmap = nullptr) {
    const int tid = tidx(), wid = __builtin_amdgcn_readfirstlane(tid >> 6), lane = tid & 63, wr = wid >> 2, wc = wid & 3, fr = lane & 15, fq = lane >> 4;
    const int nt = K / BK;
    unsigned voffB[2];
#pragma unroll
    for (int i = 0; i < 2; ++i) { int R, C; stage_rc(tid * 16 + i * 8192, R, C); const int Rb = Epi::PERM ? ((R & ~31) + perm32(R & 31)) : R;
        voffB[i] = (unsigned)(Rb * ldb + C) * 2u; }
    unsigned gc[2][2], gn[GATHER ? 2 : 1][2];
#define PG8_AOFFS(g, ui_) do { _Pragma("unroll") for (int h_ = 0; h_ < 2; ++h_) _Pragma("unroll") for (int i_ = 0; i_ < 2; ++i_) { int R_, C_; stage_rc(tid * 16 + i_ * 8192, R_, C_); const int r_ = h_ * HALF + R_; \
        const int t_ = GATHER ? tokmap[(ui_) * 256 + r_] : r_; g[h_][i_] = (unsigned)(t_ * lda + C_) * 2u; } } while (0)
    const size_t kstep = (size_t)(BK * 2);
    const size_t hstepA = (size_t)HALF * lda * 2, hstepB = (size_t)HALF * ldb * 2;
#define PG8_STAGE_A(bufoff, base, h, o0, o1) do { if constexpr (GATHER) { if (h) PG8_STAGE(bufoff, base, o1); else PG8_STAGE(bufoff, base, o0); } \
        else { PG8_STAGE(bufoff, (base) + ((h) ? hstepA : (size_t)0), o0); } } while (0)
    const unsigned ldsw = (unsigned)wid * 1024u;
    const int aoff = lds_byte(wr * 64 + fr, fq * 8), boff = lds_byte(wc * 32 + fr, fq * 8);
#define PG8_SA(b, h) (((b) * 2 + (h)) * HTB)
#define PG8_SB(b, h) ((4 + (b) * 2 + (h)) * HTB)
#define PG8_STAGE(bufoff, gbase, voff) do { _Pragma("unroll") for (int _i = 0; _i < 2; ++_i) \
        __builtin_amdgcn_global_load_lds((const unsigned*)((const char*)(gbase) + (voff)[_i]), (LAS unsigned*)(lds + (bufoff) + ldsw + _i * 8192), 16, 0, 0); } while (0)
#define PG8_LDA(dst, b, h) do { if constexpr (F8) { _Pragma("unroll") for (int m = 0; m < 4; ++m) dst##8[m] = cat8(*(const LAS bf16x8*)(lds + PG8_SA(b, h) + aoff + m * 2048), *(const LAS bf16x8*)(lds + PG8_SA(b, h) + aoff + m * 2048 + 1024)); } \
        else { _Pragma("unroll") for (int m = 0; m < 4; ++m) _Pragma("unroll") for (int k = 0; k < 2; ++k) dst[m][k] = *(const LAS bf16x8*)(lds + PG8_SA(b, h) + aoff + m * 2048 + k * 1024); } } while (0)
#define PG8_LDB(dst, b, h) do { if constexpr (F8) { _Pragma("unroll") for (int n = 0; n < 2; ++n) dst##8[n] = cat8(*(const LAS bf16x8*)(lds + PG8_SB(b, h) + boff + n * 2048), *(const LAS bf16x8*)(lds + PG8_SB(b, h) + boff + n * 2048 + 1024)); } \
        else { _Pragma("unroll") for (int n = 0; n < 2; ++n) _Pragma("unroll") for (int k = 0; k < 2; ++k) dst[n][k] = *(const LAS bf16x8*)(lds + PG8_SB(b, h) + boff + n * 2048 + k * 1024); } } while (0)
#define PG8_MMA(ai, bj, At, Bt) do { __builtin_amdgcn_s_setprio(1); \
        if constexpr (F8) { _Pragma("unroll") for (int m = 0; m < 4; ++m) _Pragma("unroll") for (int n = 0; n < 2; ++n) \
            asm volatile("v_mfma_f32_16x16x128_f8f6f4 %0, %1, %2, %0" : "+v"(acc[ai][bj][m][n]) : "v"(Bt##8[n]), "v"(At##8[m])); }   \
        else { _Pragma("unroll") for (int m = 0; m < 4; ++m) _Pragma("unroll") for (int n = 0; n < 2; ++n) _Pragma("unroll") for (int k = 0; k < 2; ++k) \
            acc[ai][bj][m][n] = __builtin_amdgcn_mfma_f32_16x16x32_bf16(Bt[n][k], At[m][k], acc[ai][bj][m][n], 0, 0, 0); } \
        __builtin_amdgcn_s_setprio(0); } while (0)
#define PG8_WAIT_V(n) asm volatile("s_waitcnt vmcnt(" #n ")" ::: "memory")
#define PG8_WAIT_L(n) asm volatile("s_waitcnt lgkmcnt(" #n ")" ::: "memory")
#define PG8_BAR __builtin_amdgcn_s_barrier()
#define PG8_SCHED __builtin_amdgcn_sched_barrier(0)
    Unit cur, nxt; int ui = 0;
    if (!S.next(0, cur)) return;
    f32x4 acc[2][2][4][2];
#pragma unroll
    for (int a = 0; a < 2; ++a)
#pragma unroll
        for (int b = 0; b < 2; ++b)
#pragma unroll
            for (int m = 0; m < 4; ++m)
#pragma unroll
                for (int n = 0; n < 2; ++n) acc[a][b][m][n] = (f32x4){0.f, 0.f, 0.f, 0.f};
    bf16x8 At[4][2], B0[2][2], B1[2][2];
    v8i_t At8[4], B08[2], B18[2];
    const char* cA = cur.A; const char* cB = cur.B;
    PG8_AOFFS(gc, 0);
    PG8_STAGE(PG8_SB(0, 0), cB, voffB); PG8_STAGE(PG8_SB(0, 1), cB + hstepB, voffB); PG8_STAGE_A(PG8_SA(0, 0), cA, 0, gc[0], gc[1]); PG8_STAGE_A(PG8_SA(0, 1), cA, 1, gc[0], gc[1]);
    if (wr == 1) PG8_BAR;
    PG8_WAIT_V(2); PG8_BAR;
    PG8_STAGE(PG8_SB(1, 0), cB + kstep, voffB); PG8_STAGE_A(PG8_SA(1, 0), cA + kstep, 0, gc[0], gc[1]); PG8_STAGE(PG8_SB(1, 1), cB + hstepB + kstep, voffB);
    PG8_WAIT_V(6); PG8_BAR;
    for (;;) {
        const bool has_next = S.next(ui + 1, nxt);
        const char* nA = has_next ? nxt.A : cA; const char* nB = has_next ? nxt.B : cB;
        if constexpr (GATHER) { if (has_next) { PG8_AOFFS(gn, ui + 1); } else {
#pragma unroll
            for (int h_ = 0; h_ < 2; ++h_)
#pragma unroll
                for (int i_ = 0; i_ < 2; ++i_) gn[h_][i_] = gc[h_][i_]; } }
        int ntu = nt; if constexpr (sched_var_k<Sched>::value) ntu = S.nt_of(cur);
#pragma unroll 1
        for (int t = 0; t < ntu; t += 2) {
            const bool last = (t == ntu - 2);
            const char* a1 = cA + (size_t)(t + 1) * kstep;
            const char* a2 = last ? nA : cA + (size_t)(t + 2) * kstep; const char* b2 = last ? nB : cB + (size_t)(t + 2) * kstep;
            const char* a3 = a2 + kstep; const char* b3 = b2 + kstep;
            unsigned g0[2], g1[2];
#pragma unroll
            for (int i_ = 0; i_ < 2; ++i_) { if constexpr (GATHER) { g0[i_] = last ? gn[0][i_] : gc[0][i_]; g1[i_] = last ? gn[1][i_] : gc[1][i_]; } else { g0[i_] = gc[0][i_]; g1[i_] = gc[1][i_]; } }
            PG8_LDB(B0, 0, 0); PG8_LDB(B1, 0, 1); PG8_SCHED; PG8_LDA(At, 0, 0); PG8_STAGE_A(PG8_SA(1, 1), a1, 1, gc[0], gc[1]);
            PG8_WAIT_V(8); PG8_WAIT_L(0); PG8_BAR; PG8_MMA(0, 0, At, B0); PG8_MMA(0, 1, At, B1); PG8_BAR; PG8_SCHED;
            PG8_LDA(At, 0, 1); PG8_STAGE(PG8_SB(0, 0), b2, voffB); PG8_STAGE(PG8_SB(0, 1), b2 + hstepB, voffB); PG8_STAGE_A(PG8_SA(0, 0), a2, 0, g0, g1);
            PG8_WAIT_V(8); PG8_WAIT_L(0); PG8_BAR; PG8_MMA(1, 0, At, B0); PG8_MMA(1, 1, At, B1); PG8_BAR; PG8_SCHED;
            PG8_LDB(B0, 1, 0); PG8_LDB(B1, 1, 1); PG8_SCHED; PG8_LDA(At, 1, 0); PG8_STAGE_A(PG8_SA(0, 1), a2, 1, g0, g1);
            PG8_WAIT_V(8); PG8_WAIT_L(0); PG8_BAR; PG8_MMA(0, 0, At, B0); PG8_MMA(0, 1, At, B1); PG8_BAR; PG8_SCHED;
            PG8_LDA(At, 1, 1); PG8_STAGE(PG8_SB(1, 0), b3, voffB); PG8_STAGE(PG8_SB(1, 1), b3 + hstepB, voffB); PG8_STAGE_A(PG8_SA(1, 0), a3, 0, g0, g1);
            PG8_WAIT_V(8); PG8_WAIT_L(0); PG8_BAR; PG8_MMA(1, 0, At, B0); PG8_MMA(1, 1, At, B1); PG8_BAR; PG8_SCHED;
        }
        if (wr == 0) PG8_BAR;
        if constexpr (F8) asm volatile("s_nop 15\n\ts_nop 15" ::: "memory");
        E(acc, cur, wr, wc, fr, fq);
        if (!has_next) break;
        if (!(epi_chain<Epi>::value && cur.aux == 0)) {
#pragma unroll
        for (int a = 0; a < 2; ++a)
#pragma unroll
            for (int b = 0; b < 2; ++b)
#pragma unroll
                for (int m = 0; m < 4; ++m)
#pragma unroll
                    for (int n = 0; n < 2; ++n) acc[a][b][m][n] = (f32x4){0.f, 0.f, 0.f, 0.f};
        }
        cur = nxt; cA = nA; cB = nB; ++ui;
        if constexpr (GATHER) {
#pragma unroll
            for (int h_ = 0; h_ < 2; ++h_)
#pragma unroll
                for (int i_ = 0; i_ < 2; ++i_) gc[h_][i_] = gn[h_][i_]; }
        if (wr == 1) PG8_BAR;
    }
    PG8_WAIT_V(0);
    PG8_BAR;
#undef PG8_AOFFS
#undef PG8_STAGE_A
#undef PG8_SA
#undef PG8_SB
#undef PG8_STAGE
#undef PG8_LDA
#undef PG8_LDB
#undef PG8_MMA
#undef PG8_WAIT_V
#undef PG8_WAIT_L
#undef PG8_BAR
#undef PG8_SCHED
}

#define EPI_LOOP_AIM _Pragma("unroll") for (int ai = 0; ai < 2; ++ai) _Pragma("unroll") for (int m = 0; m < 4; ++m)
struct EpiProj {
    static constexpr bool PERM = true;
    bf16_t* O; float* ssq_q; float* ssq_kv;
    DI void operator()(const f32x4 (&acc)[2][2][4][2], const Unit& u, int wr, int wc, int fr, int fq) const {
        const int row0 = u.pm * BM + wr * 64 + fr, col0 = u.pn * BM + wc * 32 + 8 * fq;
        const bool sq = (u.pn == 24 || u.pn == 25), skv = (u.pn == 26);
        EPI_LOOP_AIM { const int row = row0 + ai * HALF + m * 16; bf16_t* rowp = O + (size_t)row * NP + col0; float ss = 0.f;
#pragma unroll
            for (int bj = 0; bj < 2; ++bj) { const f32x4 v0 = acc[ai][bj][m][0], v1 = acc[ai][bj][m][1];
                u32x4 w; w.x = pk2(v0[0], v0[1]); w.y = pk2(v0[2], v0[3]); w.z = pk2(v1[0], v1[1]); w.w = pk2(v1[2], v1[3]);
                *(u32x4*)(rowp + bj * HALF) = w;
                ss += (v0[0] * v0[0] + v0[1] * v0[1]) + (v0[2] * v0[2] + v0[3] * v0[3]) + (v1[0] * v1[0] + v1[1] * v1[1]) + (v1[2] * v1[2] + v1[3] * v1[3]); }
            if (sq || skv) { ss += __shfl_xor(ss, 16); ss += __shfl_xor(ss, 32);
                if (fq == 0) { if (sq) ssq_q[(size_t)row * 8 + (u.pn - 24) * 4 + wc] = ss; else ssq_kv[(size_t)row * 4 + wc] = ss; } }
        }
    }
};
struct EpiQ {
    static constexpr bool PERM = true;
    bf16_t* Q; const float* ssq_q; const f32x2* rope;
    DI void operator()(const f32x4 (&acc)[2][2][4][2], const Unit& u, int wr, int wc, int fr, int fq) const {
        const int row0 = u.pm * BM + wr * 64 + fr, col0 = u.pn * BM + wc * 32 + 8 * fq;
        EPI_LOOP_AIM { const int row = row0 + ai * HALF + m * 16; const int pos = row & (SEQ - 1);
            const f32x4 s0 = *(const f32x4*)(ssq_q + (size_t)row * 8), s1 = *(const f32x4*)(ssq_q + (size_t)row * 8 + 4);
            const float rs = rsqrtf(((s0[0] + s0[1]) + (s0[2] + s0[3]) + (s1[0] + s1[1]) + (s1[2] + s1[3])) * (1.f / 512.f) + EPS) * QSCALE;
#pragma unroll
            for (int bj = 0; bj < 2; ++bj) { const int c = col0 + bj * HALF; const int j = c % 192;
                f32x4 v0 = acc[ai][bj][m][0] * rs, v1 = acc[ai][bj][m][1] * rs;
                if (j >= 128) { const int i0 = (j - 128) >> 1; const f32x2* rp = rope + (size_t)pos * 32 + i0;
                    const f32x2 c0 = rp[0], c1 = rp[1], c2 = rp[2], c3 = rp[3];
                    f32x4 w0, w1;
                    w0[0] = v0[0] * c0.x - v0[1] * c0.y; w0[1] = v0[1] * c0.x + v0[0] * c0.y; w0[2] = v0[2] * c1.x - v0[3] * c1.y; w0[3] = v0[3] * c1.x + v0[2] * c1.y;
                    w1[0] = v1[0] * c2.x - v1[1] * c2.y; w1[1] = v1[1] * c2.x + v1[0] * c2.y; w1[2] = v1[2] * c3.x - v1[3] * c3.y; w1[3] = v1[3] * c3.x + v1[2] * c3.y;
                    v0 = w0; v1 = w1; }
                u32x4 w; w.x = pk2(v0[0], v0[1]); w.y = pk2(v0[2], v0[3]); w.z = pk2(v1[0], v1[1]); w.w = pk2(v1[2], v1[3]);
                *(u32x4*)(Q + (size_t)row * 1536 + c) = w; }
        }
    }
};
struct EpiKV {
    static constexpr bool PERM = true;
    bf16_t* Kb; bf16_t* Vb; const float* ssq_kv;
    DI void operator()(const f32x4 (&acc)[2][2][4][2], const Unit& u, int wr, int wc, int fr, int fq) const {
        const int row0 = u.pm * BM + wr * 64 + fr, cc = wc * 32 + 8 * fq, hd = u.pn;
        EPI_LOOP_AIM { const int row = row0 + ai * HALF + m * 16;
            const f32x4 s0 = *(const f32x4*)(ssq_kv + (size_t)row * 4);
            const float rs = rsqrtf(((s0[0] + s0[1]) + (s0[2] + s0[3])) * (1.f / 256.f) + EPS);
#pragma unroll
            for (int bj = 0; bj < 2; ++bj) { const f32x4 v0 = acc[ai][bj][m][0] * rs, v1 = acc[ai][bj][m][1] * rs;
                u32x4 w; w.x = pk2(v0[0], v0[1]); w.y = pk2(v0[2], v0[3]); w.z = pk2(v1[0], v1[1]); w.w = pk2(v1[2], v1[3]);
                const unsigned th = (unsigned)(((row >> 13) * 8 + hd) * 128 + ((row & (SEQ - 1)) >> 6)), rr = (unsigned)(row & 63);
                if (bj == 0) *(u32x4*)(Kb + (th * 12288u + (unsigned)(cc >> 3) * 512u + rr * 8u)) = w;
                else *(u32x4*)(Vb + (th * 8192u + (unsigned)(cc >> 4) * 1024u + rr * 16u + (unsigned)(cc & 15))) = w; }
        }
    }
};
struct EpiMerge {
    static constexpr bool PERM = true, CHAIN = true;
    bf16_t* MG; const bf16_t* proj;
    DI void operator()(f32x4 (&acc)[2][2][4][2], const Unit& u, int wr, int wc, int fr, int fq) const {
        const int row0 = u.pm * BM + wr * 64 + fr, col0 = u.pn * BM + wc * 32 + 8 * fq;
        if (u.aux == 0) {
            EPI_LOOP_AIM { const int row = row0 + ai * HALF + m * 16;
#pragma unroll
                for (int bj = 0; bj < 2; ++bj) { const unsigned po = (unsigned)row * (unsigned)NP + (unsigned)(col0 + bj * HALF);
                    const u32x4 ga = __builtin_nontemporal_load((const u32x4*)(proj + (po + C_GA))), gb = *(const u32x4*)(proj + (po + C_GB));
                    const unsigned gaw[4] = {ga.x, ga.y, ga.z, ga.w}, gbw[4] = {gb.x, gb.y, gb.z, gb.w};
#pragma unroll
                    for (int q = 0; q < 4; ++q) { const float r0 = (1.f + __expf(-bflo(gbw[q]))) * __builtin_amdgcn_rcpf(1.f + __expf(-bflo(gaw[q]))), r1 = (1.f + __expf(-bfhi(gbw[q]))) * __builtin_amdgcn_rcpf(1.f + __expf(-bfhi(gaw[q])));
                        acc[ai][bj][m][q >> 1][(q & 1) * 2] *= r0; acc[ai][bj][m][q >> 1][(q & 1) * 2 + 1] *= r1; } }
            }
        } else {
            EPI_LOOP_AIM { const int row = row0 + ai * HALF + m * 16;
#pragma unroll
                for (int bj = 0; bj < 2; ++bj) { const int c = col0 + bj * HALF;
                    const u32x4 g = *(const u32x4*)(proj + ((unsigned)row * (unsigned)NP + (unsigned)(C_GB + c)));
                    const f32x4 v0 = acc[ai][bj][m][0], v1 = acc[ai][bj][m][1];
                    u32x4 w; w.x = pk2(sigmoidf_(bflo(g.x)) * v0[0], sigmoidf_(bfhi(g.x)) * v0[1]); w.y = pk2(sigmoidf_(bflo(g.y)) * v0[2], sigmoidf_(bfhi(g.y)) * v0[3]);
                    w.z = pk2(sigmoidf_(bflo(g.z)) * v1[0], sigmoidf_(bfhi(g.z)) * v1[1]); w.w = pk2(sigmoidf_(bflo(g.w)) * v1[2], sigmoidf_(bfhi(g.w)) * v1[3]);
                    *(u32x4*)(MG + (size_t)row * DM + c) = w; }
            }
        }
    }
};
struct EpiRes {
    static constexpr bool PERM = false;
    const float* X; float* X1;
    DI void operator()(const f32x4 (&acc)[2][2][4][2], const Unit& u, int wr, int wc, int fr, int fq) const {
        const int row0 = u.pm * BM + wr * 64 + fr, col0 = u.pn * BM + wc * 32 + 4 * fq;
        EPI_LOOP_AIM { const size_t off = (size_t)(row0 + ai * HALF + m * 16) * DM + col0;
#pragma unroll
            for (int bj = 0; bj < 2; ++bj)
#pragma unroll
                for (int n = 0; n < 2; ++n) { const f32x4 b = __builtin_nontemporal_load((const f32x4*)(X + off + bj * HALF + n * 16)); *(f32x4*)(X1 + off + bj * HALF + n * 16) = b + acc[ai][bj][m][n]; }
        }
    }
};
struct EpiGU {
    static constexpr bool PERM = true;
    bf16_t* ACT; const float* bias;
    DI void operator()(const f32x4 (&acc)[2][2][4][2], const Unit& u, int wr, int wc, int fr, int fq) const {
        const int row0 = u.pm * BM + wr * 64 + fr, col0 = u.pn * BM + wc * 32 + 8 * fq;
        const float* bp = bias + (size_t)u.aux * 2048 + col0;
        f32x4 bv[2][2];
#pragma unroll
        for (int bj = 0; bj < 2; ++bj) { bv[bj][0] = *(const f32x4*)(bp + bj * HALF); bv[bj][1] = *(const f32x4*)(bp + bj * HALF + 4); }
        EPI_LOOP_AIM { const int row = row0 + ai * HALF + m * 16;
#pragma unroll
            for (int bj = 0; bj < 2; ++bj) { const f32x4 v0 = acc[ai][bj][m][0] * F8_UNSCALE + bv[bj][0], v1 = acc[ai][bj][m][1] * F8_UNSCALE + bv[bj][1];
                float a[4];
                { const float g = fminf(v0[0], 7.f), up = fminf(fmaxf(v0[1], -7.f), 7.f); a[0] = (up + 1.f) * (g * sigmoidf_(1.702f * g)); }
                { const float g = fminf(v0[2], 7.f), up = fminf(fmaxf(v0[3], -7.f), 7.f); a[1] = (up + 1.f) * (g * sigmoidf_(1.702f * g)); }
                { const float g = fminf(v1[0], 7.f), up = fminf(fmaxf(v1[1], -7.f), 7.f); a[2] = (up + 1.f) * (g * sigmoidf_(1.702f * g)); }
                { const float g = fminf(v1[2], 7.f), up = fminf(fmaxf(v1[3], -7.f), 7.f); a[3] = (up + 1.f) * (g * sigmoidf_(1.702f * g)); }
                constexpr float sc = (float)(1 << F8_CSHIFT);
                int pk = __builtin_amdgcn_cvt_pk_fp8_f32(a[0] * sc, a[1] * sc, 0, false); pk = __builtin_amdgcn_cvt_pk_fp8_f32(a[2] * sc, a[3] * sc, pk, true);
                *(int*)((unsigned char*)ACT + (size_t)row * 1024 + ((col0 + bj * HALF) >> 1)) = pk; }
        }
    }
};
struct EpiDown {
    static constexpr bool PERM = true;
    bf16_t* YS; const float* bias;
    DI void operator()(const f32x4 (&acc)[2][2][4][2], const Unit& u, int wr, int wc, int fr, int fq) const {
        const int row0 = u.pm * BM + wr * 64 + fr, col0 = u.pn * BM + wc * 32 + 8 * fq;
        const float* bp = bias + (size_t)u.aux * 1024 + col0;
        f32x4 bv[2][2];
#pragma unroll
        for (int bj = 0; bj < 2; ++bj) { bv[bj][0] = *(const f32x4*)(bp + bj * HALF); bv[bj][1] = *(const f32x4*)(bp + bj * HALF + 4); }
        EPI_LOOP_AIM { const int row = row0 + ai * HALF + m * 16;
#pragma unroll
            for (int bj = 0; bj < 2; ++bj) { const f32x4 v0 = acc[ai][bj][m][0] * F8_UNSCALE_DOWN + bv[bj][0], v1 = acc[ai][bj][m][1] * F8_UNSCALE_DOWN + bv[bj][1];
                constexpr float sc = (float)(1 << F8_YSHIFT);
                int p0 = __builtin_amdgcn_cvt_pk_fp8_f32(__builtin_amdgcn_fmed3f(v0[0] * sc, -448.f, 448.f), __builtin_amdgcn_fmed3f(v0[1] * sc, -448.f, 448.f), 0, false);
                p0 = __builtin_amdgcn_cvt_pk_fp8_f32(__builtin_amdgcn_fmed3f(v0[2] * sc, -448.f, 448.f), __builtin_amdgcn_fmed3f(v0[3] * sc, -448.f, 448.f), p0, true);
                int p1 = __builtin_amdgcn_cvt_pk_fp8_f32(__builtin_amdgcn_fmed3f(v1[0] * sc, -448.f, 448.f), __builtin_amdgcn_fmed3f(v1[1] * sc, -448.f, 448.f), 0, false);
                p1 = __builtin_amdgcn_cvt_pk_fp8_f32(__builtin_amdgcn_fmed3f(v1[2] * sc, -448.f, 448.f), __builtin_amdgcn_fmed3f(v1[3] * sc, -448.f, 448.f), p1, true);
                u32x2 w; w.x = (unsigned)p0; w.y = (unsigned)p1;
                *(u32x2*)((unsigned char*)YS + (size_t)row * 1024 + col0 + bj * HALF) = w; }
        }
    }
};
struct EpiQKV {
    static constexpr bool PERM = true;
    EpiQ q; EpiKV kv;
    DI void operator()(const f32x4 (&acc)[2][2][4][2], const Unit& u, int wr, int wc, int fr, int fq) const { if (u.aux) kv(acc, u, wr, wc, fr, fq); else q(acc, u, wr, wc, fr, fq); }
};
}

struct Args { const float* in[22]; float* out; unsigned char* ws; int ph_lo, ph_hi; };
enum { I_X = 0, I_NMIX, I_WIN, I_CONVW, I_ALOG, I_DTB, I_GNW, I_WGDNO, I_QNW, I_WQB, I_KVNW, I_WKVB, I_WMLAO, I_WOUT, I_NFFN, I_WR, I_BR, I_WGU, I_BGU, I_WD, I_BD, I_NFIN };

__constant__ double ROPE_REV[32] = {
    0.15915494309189535, 0.11934937021124886, 0.08949940160889101, 0.06711508300522726, 0.050329212104487035, 0.03774158471741977, 0.0283021958306234, 0.02122365276477766,
    0.015915494309189534, 0.011934937021124886, 0.008949940160889102, 0.006711508300522725, 0.005032921210448704, 0.003774158471741977, 0.00283021958306234, 0.0021223652764777662,
    0.0015915494309189536, 0.0011934937021124885, 0.0008949940160889102, 0.0006711508300522726, 0.0005032921210448703, 0.00037741584717419774, 0.00028302195830623395, 0.0002122365276477766,
    0.00015915494309189535, 0.00011934937021124886, 8.949940160889102e-05, 6.711508300522725e-05, 5.0329212104487035e-05, 3.774158471741978e-05, 2.8302195830623396e-05, 2.122365276477766e-05};

struct MapId { DI int operator()(int n) const { return n; } };
struct MapWin { DI int operator()(int n) const {
    if (n < 4096) return n;
    if (n < 5120) return 4944 + (n - 4096);
    if (n < 6144) return 5968 + (n - 5120);
    if (n < 6656) return 4112 + (n - 6144);
    if (n < 6912) return 4624 + (n - 6656);
    if (n < 6976) { const int j = n - 6912; return 4880 + (j >> 1) + 32 * (j & 1); }
    if (n < 6984) return 4096 + (n - 6976);
    if (n < 6992) return 4104 + (n - 6984);
    return -1; } };
struct MapQb { DI int operator()(int n) const { const int hd = n / 192, j = n % 192; if (j < 128) return n; const int jj = j - 128; return hd * 192 + 128 + (jj >> 1) + 32 * (jj & 1); } };

template <class Map, bool NT_STORE = false>
DI void tr_item(const float* __restrict__ W, int ldw, bf16_t* WT, int K, int nblk, int item, const float* kscale, LAS float* scr, int lane, Map map) {
    const int kb = item / nblk, nb = item % nblk, k0 = 64 * kb, n0 = 64 * nb;
    const int kq = lane >> 4, n4 = 4 * (lane & 15);
    const int sc = map(n0 + n4);
    const bool contig = (sc >= 0) && (map(n0 + n4 + 1) == sc + 1) && (map(n0 + n4 + 2) == sc + 2) && (map(n0 + n4 + 3) == sc + 3);
    f32x4 v[16];
    if (contig) {
#pragma unroll
        for (int i = 0; i < 16; ++i) v[i] = __builtin_nontemporal_load((const f32x4*)(W + (size_t)(k0 + 4 * i + kq) * ldw + sc));
    } else {
        const int s0 = map(n0 + n4), s1 = map(n0 + n4 + 1), s2 = map(n0 + n4 + 2), s3 = map(n0 + n4 + 3);
#pragma unroll
        for (int i = 0; i < 16; ++i) { const float* wr = W + (size_t)(k0 + 4 * i + kq) * ldw;
            v[i][0] = s0 >= 0 ? wr[s0] : 0.f; v[i][1] = s1 >= 0 ? wr[s1] : 0.f; v[i][2] = s2 >= 0 ? wr[s2] : 0.f; v[i][3] = s3 >= 0 ? wr[s3] : 0.f; }
    }
#pragma unroll
    for (int i = 0; i < 16; ++i) { const int kk = 4 * i + kq; f32x4 x = v[i]; if (kscale) x = x * kscale[k0 + kk];
        scr[kk * 65 + n4] = x[0]; scr[kk * 65 + n4 + 1] = x[1]; scr[kk * 65 + n4 + 2] = x[2]; scr[kk * 65 + n4 + 3] = x[3]; }
    LDS_WAIT();
    const int c = lane & 7;
#pragma unroll
    for (int j = 0; j < 8; ++j) { const int n = (lane >> 3) + 8 * j; const LAS float* s = scr + (8 * c) * 65 + n;
        u32x4 o; o.x = pk2(s[0], s[65]); o.y = pk2(s[2 * 65], s[3 * 65]); o.z = pk2(s[4 * 65], s[5 * 65]); o.w = pk2(s[6 * 65], s[7 * 65]);
        if (NT_STORE) __builtin_nontemporal_store(o, (u32x4*)(WT + (size_t)(n0 + n) * K + k0 + 8 * c)); else *(u32x4*)(WT + (size_t)(n0 + n) * K + k0 + 8 * c) = o; }
    LDS_WAIT();
}

DI void phase_prologue(const Args& a, LAS unsigned char* lds) {
    const int tid = tidx(), lane = tid & 63, wave = tid >> 6;
    const int gw = blockIdx.x * 8 + wave, NGW = gridDim.x * 8;
    LAS float* scr = (LAS float*)(lds + wave * 16640);
    unsigned char* ws = a.ws;
    constexpr int N0 = 1792, N1 = 256, N4 = 192, N5 = 128;
    constexpr int NITEMS = N0 + 3 * N1 + N4 + N5;
    for (int it = gw; it < NITEMS; it += NGW) {
        int r = it;
        if (r < N1) { tr_item(a.in[I_WGDNO], 1024, (bf16_t*)(ws + WS_WGDNO), 1024, 16, r, nullptr, scr, lane, MapId()); continue; } r -= N1;
        if (r < N1) { tr_item(a.in[I_WMLAO], 1024, (bf16_t*)(ws + WS_WMLAO), 1024, 16, r, nullptr, scr, lane, MapId()); continue; } r -= N1;
        if (r < N1) { tr_item(a.in[I_WOUT], 1024, (bf16_t*)(ws + WS_WOUT), 1024, 16, r, nullptr, scr, lane, MapId()); continue; } r -= N1;
        if (r < N4) { tr_item(a.in[I_WQB], 1536, (bf16_t*)(ws + WS_WQB), 512, 24, r, a.in[I_QNW], scr, lane, MapQb()); continue; } r -= N4;
        if (r < N5) { tr_item(a.in[I_WKVB], 2048, (bf16_t*)(ws + WS_WKVB), 512, 32, r, a.in[I_KVNW], scr, lane, MapId());     continue; } r -= N5;
        tr_item(a.in[I_WIN], 6992, (bf16_t*)(ws + WS_WIN), 1024, 112, r, nullptr, scr, lane, MapWin());
    }
    {
        const float* nw = a.in[I_NMIX]; bf16_t* XN = (bf16_t*)(ws + WS_XN);
        f32x4 wv[4];
#pragma unroll
        for (int j = 0; j < 4; ++j) wv[j] = *(const f32x4*)(nw + 256 * j + 4 * lane);
#pragma unroll 2
        for (int m = gw; m < T_TOK; m += NGW) {
            const float* xr = a.in[I_X] + (size_t)m * DM + 4 * lane; f32x4 v[4]; float s = 0.f;
#pragma unroll
            for (int j = 0; j < 4; ++j) { v[j] = __builtin_nontemporal_load((const f32x4*)(xr + 256 * j)); s += (v[j][0] * v[j][0] + v[j][1] * v[j][1]) + (v[j][2] * v[j][2] + v[j][3] * v[j][3]); }
            const float rs = rsqrtf(wave_sum(s) * (1.f / DM) + EPS);
            bf16_t* o = XN + (size_t)m * DM + 4 * lane;
#pragma unroll
            for (int j = 0; j < 4; ++j) { u32x2 w; w.x = pk2(v[j][0] * rs * wv[j][0], v[j][1] * rs * wv[j][1]); w.y = pk2(v[j][2] * rs * wv[j][2], v[j][3] * rs * wv[j][3]); *(u32x2*)(o + 256 * j) = w; }
        }
    }
    {
        f32x2* rt = (f32x2*)(ws + WS_ROPE);
        for (int idx = blockIdx.x * 512 + tid; idx < SEQ * 32; idx += gridDim.x * 512) {
            const int pos = idx >> 5, i = idx & 31; const double rev = (double)pos * ROPE_REV[i]; const float fr = (float)(rev - floor(rev));
            f32x2 cs; cs.x = __builtin_amdgcn_cosf(fr); cs.y = __builtin_amdgcn_sinf(fr); rt[idx] = cs;
        }
    }
}

constexpr int PL_KN = 0, PL_QN = 17408, PL_VB = 34816, PL_LD = 52224, PL_LB = 57344, PL_SM = 66560, PL_QKM = 67584, PL_X = 76800, PL_CW = 142336;
DI void gdn_prep_load(const Args& a, int bh, int ch, int tid, u32x4 (&xr)[3][5]) {
    const int b = bh >> 3, h = bh & 7, cgi = tid & 15, tg = tid >> 4; const int s0 = ch * 64 + 2 * tg - 3;
    const bf16_t* proj = (const bf16_t*)(a.ws + WS_PROJ); const size_t rowb = (size_t)b * SEQ;
#pragma unroll
    for (int p = 0; p < 3; ++p) { const int col = p * 1024 + h * 128 + 8 * cgi;
#pragma unroll
        for (int r = 0; r < 5; ++r) { const int s = s0 + r; xr[p][r] = (s >= 0) ? *(const u32x4*)(proj + (rowb + s) * NP + col) : (u32x4){0u, 0u, 0u, 0u}; } }
}
DI void gdn_prep_unit(const Args& a, LAS unsigned char* lds, int bh, int ch, u32x4 (&xr)[3][5], int bh_n, int ch_n, bool load_w) {
    const int tid = tidx(), lane = tid & 63, wid = __builtin_amdgcn_readfirstlane(tid >> 6);
    const int b = bh >> 3, h = bh & 7;
    LAS bf16_t* KN = (LAS bf16_t*)(lds + PL_KN); LAS bf16_t* QN = (LAS bf16_t*)(lds + PL_QN); LAS bf16_t* VB = (LAS bf16_t*)(lds + PL_VB);
    LAS float* LD = (LAS float*)(lds + PL_LD); LAS bf16_t* LB = (LAS bf16_t*)(lds + PL_LB); LAS float* XS_ = (LAS float*)(lds + PL_X); LAS float* SM = (LAS float*)(lds + PL_SM); LAS bf16_t* QKM = (LAS bf16_t*)(lds + PL_QKM);
    LAS float* BETA = SM; LAS float* GC = SM + 128; LAS float* EG = SM + 192;
    const bf16_t* proj = (const bf16_t*)(a.ws + WS_PROJ);
    const size_t rowb = (size_t)b * SEQ;
    LAS float* CW = (LAS float*)(lds + PL_CW);
    if (load_w) {
        if (tid < 384) {
#pragma unroll
            for (int j = 0; j < 4; ++j) CW[j * 384 + tid] = a.in[I_CONVW][j * 3072 + (tid >> 7) * 1024 + h * 128 + (tid & 127)]; }
        __syncthreads();
    }
    {
        const int cgi = tid & 15, tg = tid >> 4;
        const float beta0 = sigmoidf_(bf2f(proj[(rowb + ch * 64 + 2 * tg) * NP + C_BG + h])), beta1 = sigmoidf_(bf2f(proj[(rowb + ch * 64 + 2 * tg + 1) * NP + C_BG + h]));
        if (wid == 0) {
            const float A = __expf(a.in[I_ALOG][h]), dtb = a.in[I_DTB][h];
            const float xg = bf2f(proj[(rowb + ch * 64 + lane) * NP + C_AG + h]) + dtb, bt = sigmoidf_(bf2f(proj[(rowb + ch * 64 + lane) * NP + C_BG + h]));
            float x = -A * (fmaxf(xg, 0.f) + log1pf(__expf(-fabsf(xg))));
#pragma unroll
            for (int d = 1; d < 64; d <<= 1) { const float v = __shfl_up(x, d); if (lane >= d) x += v; }
            BETA[lane] = bt; GC[lane] = x; EG[lane] = __expf(x);
            if (lane == 63) ((float*)(a.ws + WS_GLAST))[bh * 128 + ch] = __expf(x);
        }
#pragma unroll
        for (int p = 0; p < 3; ++p) {
            const int col = p * 1024 + h * 128 + 8 * cgi;
            float y0[8], y1[8];
#pragma unroll
            for (int e = 0; e < 8; ++e) { y0[e] = 0.f; y1[e] = 0.f; }
#pragma unroll
            for (int j = 0; j < 4; ++j) {
                const f32x4 wa = *(const LAS f32x4*)(CW + j * 384 + p * 128 + 8 * cgi), wb = *(const LAS f32x4*)(CW + j * 384 + p * 128 + 8 * cgi + 4);
                const float w8[8] = {wa[0], wa[1], wa[2], wa[3], wb[0], wb[1], wb[2], wb[3]};
                const u32x4 r0 = xr[p][j], r1 = xr[p][j + 1];
                const float x0[8] = {bflo(r0.x), bfhi(r0.x), bflo(r0.y), bfhi(r0.y), bflo(r0.z), bfhi(r0.z), bflo(r0.w), bfhi(r0.w)};
                const float x1[8] = {bflo(r1.x), bfhi(r1.x), bflo(r1.y), bfhi(r1.y), bflo(r1.z), bfhi(r1.z), bflo(r1.w), bfhi(r1.w)};
#pragma unroll
                for (int e = 0; e < 8; ++e) { y0[e] += w8[e] * x0[e]; y1[e] += w8[e] * x1[e]; }
            }
            float ss0 = 0.f, ss1 = 0.f;
#pragma unroll
            for (int e = 0; e < 8; ++e) { y0[e] = y0[e] * sigmoidf_(y0[e]); y1[e] = y1[e] * sigmoidf_(y1[e]); ss0 += y0[e] * y0[e]; ss1 += y1[e] * y1[e]; }
            float f0, f1;
            if (p < 2) {
#pragma unroll
                for (int o = 1; o < 16; o <<= 1) { ss0 += __shfl_xor(ss0, o); ss1 += __shfl_xor(ss1, o); }
                const float sc = (p == 0) ? 0.08838834764831845f : 1.f;
                f0 = rsqrtf(ss0 + EPS) * sc; f1 = rsqrtf(ss1 + EPS) * sc;
            } else { f0 = beta0; f1 = beta1; }
            LAS bf16_t* img = (p == 0) ? QN : (p == 1) ? KN : VB;
            u32x4 w0, w1;
            w0.x = pk2(y0[0] * f0, y0[1] * f0); w0.y = pk2(y0[2] * f0, y0[3] * f0); w0.z = pk2(y0[4] * f0, y0[5] * f0); w0.w = pk2(y0[6] * f0, y0[7] * f0);
            w1.x = pk2(y1[0] * f1, y1[1] * f1); w1.y = pk2(y1[2] * f1, y1[3] * f1); w1.z = pk2(y1[4] * f1, y1[5] * f1); w1.w = pk2(y1[6] * f1, y1[7] * f1);
            *(LAS u32x4*)(img + (2 * tg) * 136 + 8 * cgi) = w0; *(LAS u32x4*)(img + (2 * tg + 1) * 136 + 8 * cgi) = w1;
        }
    }
    if (bh_n >= 0) gdn_prep_load(a, bh_n, ch_n, tid, xr);
    __syncthreads();
    {
        const int mat = wid >> 2, ti = (wid >> 1) & 1, tj = wid & 1, r = lane & 31, hh = lane >> 5;
        LAS bf16_t* Aimg = mat ? QN : KN;
        f32x16 acc;
#pragma unroll
        for (int i = 0; i < 16; ++i) acc[i] = 0.f;
#pragma unroll
        for (int s = 0; s < 8; ++s) { const bf16x8 av = *(const LAS bf16x8*)(Aimg + (32 * ti + r) * 136 + 16 * s + 8 * hh), bv = *(const LAS bf16x8*)(KN + (32 * tj + r) * 136 + 16 * s + 8 * hh); acc = MFMA32(av, bv, acc); }
        const int mcol = 32 * tj + r; const float gm = GC[mcol];
#pragma unroll
        for (int i = 0; i < 16; ++i) { const int c = 32 * ti + crow(i, hh); const float dec = __expf(GC[c] - gm);
            if (mat == 0) { const float lv = (c > mcol) ? acc[i] * BETA[c] * dec : 0.f; LB[c * 72 + mcol] = f2bf(-lv); if ((c >> 4) == (mcol >> 4)) LD[(c >> 4) * 320 + (c & 15) * 20 + (mcol & 15)] = lv; }
            else QKM[c * 72 + mcol] = f2bf((c >= mcol) ? acc[i] * dec : 0.f); }
    }
    __syncthreads();
    unsigned char* fr = a.ws + WS_FR + (size_t)(bh * 128 + ch) * FR_UNIT;
    {
        const float gl = GC[63];
#pragma unroll
        for (int it = 0; it < 2; ++it) { const int item = tid + 512 * it, ln = item & 63, ks = (item >> 6) & 7, tile = item >> 9; const int row = 32 * tile + (ln & 31), hh = ln >> 5, d0 = 16 * ks + 4 * hh;
            const float eg = EG[row]; const u32x2 lo = *(const LAS u32x2*)(QN + row * 136 + d0), hi = *(const LAS u32x2*)(QN + row * 136 + d0 + 8);
            u32x4 w; w.x = pk2(bflo(lo.x) * eg, bfhi(lo.x) * eg); w.y = pk2(bflo(lo.y) * eg, bfhi(lo.y) * eg); w.z = pk2(bflo(hi.x) * eg, bfhi(hi.x) * eg); w.w = pk2(bflo(hi.y) * eg, bfhi(hi.y) * eg);
            *(u32x4*)(fr + FR_QD + (size_t)item * 16) = w; }
#pragma unroll
        for (int it = 0; it < 2; ++it) { const int item = tid + 512 * it, ln = item & 63, ks = (item >> 6) & 3, Tt = item >> 8; const int dk = 32 * Tt + (ln & 31), hh = ln >> 5, t0 = 16 * ks + 4 * hh;
            float v[8];
#pragma unroll
            for (int jj = 0; jj < 8; ++jj) { const int tok = t0 + 8 * (jj >> 2) + (jj & 3); v[jj] = bf2f(KN[tok * 136 + dk]) * __expf(gl - GC[tok]); }
            u32x4 w; w.x = pk2(v[0], v[1]); w.y = pk2(v[2], v[3]); w.z = pk2(v[4], v[5]); w.w = pk2(v[6], v[7]);
            *(u32x4*)(fr + FR_KD + (size_t)item * 16) = w; }
        { const int item = tid, ln = item & 63, ks = (item >> 6) & 3, tile = item >> 8; const int row = 32 * tile + (ln & 31), hh = ln >> 5, m0 = 16 * ks + 4 * hh;
            const u32x2 lo = *(const LAS u32x2*)(QKM + row * 72 + m0), hi = *(const LAS u32x2*)(QKM + row * 72 + m0 + 8);
            u32x4 w; w.x = lo.x; w.y = lo.y; w.z = hi.x; w.w = hi.y;
            *(u32x4*)(fr + FR_QK + (size_t)item * 16) = w; }
    }
    {
        const int n = lane & 31, hh = lane >> 5, col = 32 * wid + n;
        f32x16 R[2];
#pragma unroll
        for (int T = 0; T < 2; ++T)
#pragma unroll
            for (int i = 0; i < 16; ++i) { const int c = 32 * T + crow(i, hh); R[T][i] = (wid < 4) ? bf2f(VB[c * 136 + col]) : bf2f(KN[c * 136 + (col - 128)]) * (BETA[c] * EG[c]); }
        float xo[32];
#pragma unroll
        for (int b = 0; b < 4; ++b) {
            const int T = b >> 1, r0 = 8 * (b & 1);
            float x[16];
#pragma unroll
            for (int q = 0; q < 8; ++q) { const float own = R[T][r0 + q]; auto rr = __builtin_amdgcn_permlane32_swap(__float_as_uint(own), __float_as_uint(own), false, false);
                const float oth = hh ? __uint_as_float(rr[0]) : __uint_as_float(rr[1]);
                const int i0 = (q & 3) + 8 * (q >> 2);
                x[i0] = hh ? oth : own; x[i0 + 4] = hh ? own : oth; }
#pragma unroll
            for (int i = 1; i < 16; ++i) {
#pragma unroll
                for (int q = 0; q < 4; ++q) if (4 * q < i) { const f32x4 l = *(const LAS f32x4*)(LD + b * 320 + i * 20 + 4 * q);
                    x[i] -= l[0] * x[4 * q]; if (4 * q + 1 < i) x[i] -= l[1] * x[4 * q + 1]; if (4 * q + 2 < i) x[i] -= l[2] * x[4 * q + 2]; if (4 * q + 3 < i) x[i] -= l[3] * x[4 * q + 3]; }
            }
            if (b < 3) {
                const bf16x8 xb = hh ? pack8(x[8], x[9], x[10], x[11], x[12], x[13], x[14], x[15]) : pack8(x[0], x[1], x[2], x[3], x[4], x[5], x[6], x[7]);
#pragma unroll
                for (int T2 = 0; T2 < 2; ++T2) if (32 * T2 + 31 > 16 * b + 15) { const bf16x8 af = *(const LAS bf16x8*)(LB + (32 * T2 + n) * 72 + 16 * b + 8 * hh); R[T2] = MFMA32(af, xb, R[T2]); }
            }
#pragma unroll
            for (int i = 0; i < 16; ++i) { if ((b >> 1) == 0) { if (!hh) xo[16 * (b & 1) + i] = x[i]; } else { if (hh) xo[16 * (b & 1) + i] = x[i]; } }
        }
#pragma unroll
        for (int i = 0; i < 32; ++i) XS_[(32 * hh + i) * 256 + col] = xo[i];
    }
    __syncthreads();
    {
#pragma unroll
        for (int it = 0; it < 2; ++it) { const int item = tid + 512 * it, ln = item & 63, ks = (item >> 6) & 7, tile = item >> 9; const int row = 32 * tile + (ln & 31), hh = ln >> 5, d0 = 128 + 16 * ks + 4 * hh;
            const f32x4 lo = *(const LAS f32x4*)(XS_ + row * 256 + d0), hi = *(const LAS f32x4*)(XS_ + row * 256 + d0 + 8);
            u32x4 w; w.x = pk2(-lo[0], -lo[1]); w.y = pk2(-lo[2], -lo[3]); w.z = pk2(-hi[0], -hi[1]); w.w = pk2(-hi[2], -hi[3]);
            *(u32x4*)(fr + FR_NW + (size_t)item * 16) = w; }
        { const int item = tid, ln = item & 63, tile = (item >> 6) & 1, sl = item >> 7; const int col = 32 * sl + (ln & 31), hh = ln >> 5;
            unsigned w[8];
#pragma unroll
            for (int rr = 0; rr < 8; ++rr) { const int t0 = 32 * tile + crow(2 * rr, hh), t1 = 32 * tile + crow(2 * rr + 1, hh); w[rr] = pk2(XS_[t0 * 256 + col], XS_[t1 * 256 + col]); }
            u32x4 wa = {w[0], w[1], w[2], w[3]}, wb = {w[4], w[5], w[6], w[7]};
            *(u32x4*)(fr + FR_U + (size_t)item * 32) = wa; *(u32x4*)(fr + FR_U + (size_t)item * 32 + 16) = wb; }
    }
}

DI void krope_pass(const Args& a) {
    const bf16_t* proj = (const bf16_t*)(a.ws + WS_PROJ); bf16_t* Kb = (bf16_t*)(a.ws + WS_K); const f32x2* rope = (const f32x2*)(a.ws + WS_ROPE);
    for (int idx = blockIdx.x * 512 + tidx(); idx < T_TOK * 8; idx += gridDim.x * 512) {
        const int row = idx >> 3, g = idx & 7, pos = row & (SEQ - 1);
        const u32x4 v = *(const u32x4*)(proj + (size_t)row * NP + C_KR + 8 * g);
        const f32x2* rp = rope + (size_t)pos * 32 + 4 * g;
        const unsigned vv[4] = {v.x, v.y, v.z, v.w}; unsigned o[4];
#pragma unroll
        for (int q = 0; q < 4; ++q) { const float x0 = bflo(vv[q]), x1 = bfhi(vv[q]); const f32x2 cs = rp[q]; o[q] = pk2(x0 * cs.x - x1 * cs.y, x1 * cs.x + x0 * cs.y); }
        const u32x4 w = {o[0], o[1], o[2], o[3]};
        const int bb = row >> 13, sq = row & (SEQ - 1), tl = sq >> 6, rr = sq & 63;
#pragma unroll
        for (int hd = 0; hd < 8; ++hd) *(u32x4*)(Kb + ((size_t)(bb * 8 + hd) * 128 + tl) * 12288 + (16 + g) * 512 + rr * 8) = w;
    }
}

constexpr int SC_GLS = 147456;
#define GLDS16(gsrc, ldst) __builtin_amdgcn_global_load_lds((const unsigned*)(gsrc), (LAS unsigned*)(ldst), 16, 0, 0)
#define GLDS16_NT(gsrc, ldst) __builtin_amdgcn_global_load_lds((const unsigned*)(gsrc), (LAS unsigned*)(ldst), 16, 0, 2)
#define WAIT_VM0() asm volatile("s_waitcnt vmcnt(0)" ::: "memory")
#define RAW_BAR() do { asm volatile("s_waitcnt lgkmcnt(0)" ::: "memory"); __builtin_amdgcn_s_barrier(); asm volatile("" ::: "memory"); } while (0)
DI void scan_store_o(bf16_t* op, const unsigned (&opk)[16], int hh) {
#pragma unroll
    for (int tile = 0; tile < 2; ++tile)
#pragma unroll
        for (int rr = 0; rr < 8; ++rr) { const unsigned w = opk[tile * 8 + rr];
            op[(size_t)(32 * tile + crow(2 * rr, hh)) * DM] = (bf16_t)(w & 0xffffu); op[(size_t)(32 * tile + crow(2 * rr + 1, hh)) * DM] = (bf16_t)(w >> 16); }
}
DI void gdn_scan_wg(const Args& a, LAS unsigned char* lds, int bh) {
    const int tid = tidx(), lane = tid & 63, wid = __builtin_amdgcn_readfirstlane(tid >> 6);
    const int b = bh >> 3, h = bh & 7, n = lane & 31, hh = lane >> 5, sl = wid;
    const unsigned char* frb = a.ws + WS_FR + (size_t)bh * 128 * FR_UNIT;
    LAS float* gls = (LAS float*)(lds + SC_GLS);
    if (tid < 128) gls[tid] = ((const float*)(a.ws + WS_GLAST))[bh * 128 + tid];
#pragma unroll
    for (int i = 0; i < 9; ++i) { const int pc = wid + 8 * i; GLDS16_NT(frb + (size_t)pc * 1024 + lane * 16, lds + pc * 1024); }
    WAIT_VM0(); RAW_BAR();
    bf16_t* OA = (bf16_t*)(a.ws + WS_OA) + ((size_t)b * SEQ) * DM + h * 128 + 32 * sl + n;
    f32x16 S[4];
#pragma unroll
    for (int t = 0; t < 4; ++t)
#pragma unroll
        for (int i = 0; i < 16; ++i) S[t][i] = 0.f;
    unsigned opk[16];
#pragma unroll
    for (int i = 0; i < 16; ++i) opk[i] = 0u;
    for (int ch = 0; ch < 128; ++ch) {
        LAS const unsigned char* fb = lds + (ch & 1) * FR_UNIT;
        if (ch + 1 < 128) { const unsigned char* src = frb + (size_t)(ch + 1) * FR_UNIT; LAS unsigned char* dst = lds + ((ch + 1) & 1) * FR_UNIT;
#pragma unroll
            for (int i = 0; i < 9; ++i) { const int pc = wid + 8 * i; GLDS16_NT(src + (size_t)pc * 1024 + lane * 16, dst + pc * 1024); } }
        if (wid < 4) {
            if (ch > 0) scan_store_o(OA + (size_t)(ch - 1) * 64 * DM, opk, hh);
            const float gl = gls[ch];
            bf16x8 Sb[8];
#pragma unroll
            for (int t = 0; t < 4; ++t) { Sb[2 * t] = pack_step(S[t], 0); Sb[2 * t + 1] = pack_step(S[t], 1); }
            f32x16 vn[2], o[2];
#pragma unroll
            for (int tile = 0; tile < 2; ++tile) {
                const u32x4 ua = *(const LAS u32x4*)(fb + FR_U + ((sl * 2 + tile) * 64 + lane) * 32), ub = *(const LAS u32x4*)(fb + FR_U + ((sl * 2 + tile) * 64 + lane) * 32 + 16);
                const unsigned uw[8] = {ua.x, ua.y, ua.z, ua.w, ub.x, ub.y, ub.z, ub.w};
#pragma unroll
                for (int rr = 0; rr < 8; ++rr) { vn[tile][2 * rr] = bflo(uw[rr]); vn[tile][2 * rr + 1] = bfhi(uw[rr]); }
#pragma unroll
                for (int i = 0; i < 16; ++i) o[tile][i] = 0.f;
            }
#pragma unroll
            for (int ks = 0; ks < 8; ++ks)
#pragma unroll
                for (int tile = 0; tile < 2; ++tile) {
                    const bf16x8 af = *(const LAS bf16x8*)(fb + FR_NW + ((tile * 8 + ks) * 64 + lane) * 16), bq = *(const LAS bf16x8*)(fb + FR_QD + ((tile * 8 + ks) * 64 + lane) * 16);
                    vn[tile] = MFMA32(af, Sb[ks], vn[tile]); o[tile] = MFMA32(bq, Sb[ks], o[tile]); }
            bf16x8 vb[4];
#pragma unroll
            for (int tile = 0; tile < 2; ++tile) { vb[2 * tile] = pack_step(vn[tile], 0); vb[2 * tile + 1] = pack_step(vn[tile], 1); }
#pragma unroll
            for (int t = 0; t < 4; ++t)
#pragma unroll
                for (int i = 0; i < 16; ++i) S[t][i] *= gl;
#pragma unroll
            for (int ks = 0; ks < 4; ++ks) {
#pragma unroll
                for (int tile = 0; tile < 2; ++tile) { const bf16x8 af = *(const LAS bf16x8*)(fb + FR_QK + ((tile * 4 + ks) * 64 + lane) * 16); o[tile] = MFMA32(af, vb[ks], o[tile]); }
#pragma unroll
                for (int t = 0; t < 4; ++t) { const bf16x8 af = *(const LAS bf16x8*)(fb + FR_KD + ((t * 4 + ks) * 64 + lane) * 16); S[t] = MFMA32(af, vb[ks], S[t]); }
            }
#pragma unroll
            for (int tile = 0; tile < 2; ++tile)
#pragma unroll
                for (int rr = 0; rr < 8; ++rr) opk[tile * 8 + rr] = pk2(o[tile][2 * rr], o[tile][2 * rr + 1]);
        }
        WAIT_VM0(); RAW_BAR();
    }
    if (wid < 4) scan_store_o(OA + (size_t)127 * 64 * DM, opk, hh);
}

constexpr int AT_K = 0, AT_V = 73728;
DI float max3f(float a, float b, float c) { float r; asm("v_max3_f32 %0, %1, %2, %3" : "=v"(r) : "v"(a), "v"(b), "v"(c)); return r; }
constexpr int TK_STAGE = 122880, TK_NGU = 16384, TK_ITEMS = 16384 + 8192;
struct Trickle { int next, step, sa, boff; const float* wgu; const float* wd; };
DI void tk_read(LAS const unsigned char* buf, int wid, int lane, float (&f)[8]) {
    const int c = lane & 7, nn = lane >> 3;
    LAS const unsigned char* p = buf + (8 * c) * 256 + ((2 * wid + (nn >> 2) + 2 * c) & 15) * 16 + (nn & 3) * 4;
#pragma unroll
    for (int k = 0; k < 8; ++k) f[k] = *(const LAS float*)(p + k * 256);
}
DI float sat_fp8(float x) { return __builtin_amdgcn_fmed3f(x, -448.f, 448.f); }
DI unsigned pk4_fp8(float a, float b, float c, float d) { int p = __builtin_amdgcn_cvt_pk_fp8_f32(sat_fp8(a), sat_fp8(b), 0, false); p = __builtin_amdgcn_cvt_pk_fp8_f32(sat_fp8(c), sat_fp8(d), p, true); return (unsigned)p; }
DI void tk_store(const Args& a, int it, int wid, int lane, const float (&f)[8]) {
    const int c = lane & 7, nn = lane >> 3;
    unsigned char* WT;
    if (it < TK_NGU) { const int e = it >> 9, ri = it & 511, kb = ri >> 5, nb = ri & 31; WT = a.ws + WS_WGU + ((size_t)e * 2048 * 1024 + (size_t)(64 * nb) * 1024 + 64 * kb); }
    else { const int r = it - TK_NGU, e = r >> 8, ri = r & 255, kb = ri >> 4, nb = ri & 15; WT = a.ws + WS_WD + ((size_t)e * 1024 * 1024 + (size_t)(64 * nb) * 1024 + 64 * kb); }
    unsigned voff = (unsigned)((8 * wid + nn) * 1024 + 8 * c); asm volatile("" : "+v"(voff));
    constexpr float sc = (float)(1 << pg8::F8_WSHIFT);
    u32x2 w; w.x = pk4_fp8(f[0] * sc, f[1] * sc, f[2] * sc, f[3] * sc); w.y = pk4_fp8(f[4] * sc, f[5] * sc, f[6] * sc, f[7] * sc);
    __builtin_nontemporal_store(w, (u32x2*)(WT + voff));
}
DI void tk_stage(const Trickle& tk, LAS unsigned char* buf, int it, int wid, int lane) {
    const unsigned char* W; int sh;
    if (it < TK_NGU) { const int e = it >> 9, ri = it & 511, kb = ri >> 5, nb = ri & 31; sh = 13; W = (const unsigned char*)(tk.wgu + (size_t)e * 1024 * 2048 + (size_t)(64 * kb) * 2048 + 64 * nb); }
    else { const int r = it - TK_NGU, e = r >> 8, ri = r & 255, kb = ri >> 4, nb = ri & 15; sh = 12; W = (const unsigned char*)(tk.wd + (size_t)e * 1024 * 1024 + (size_t)(64 * kb) * 1024 + 64 * nb); }
    const unsigned voff = ((unsigned)(8 * wid + (lane >> 4)) << sh) + (unsigned)(((lane - 2 * wid) & 15) * 16);
    GLDS16_NT(W + voff, buf + wid * 2048); GLDS16_NT(W + ((size_t)4 << sh) + voff, buf + wid * 2048 + 1024);
}
DI int tk_step(LAS unsigned char* lds, Trickle& tk, int wid, int lane, float (&f)[8]) {
    const int cv = tk.sa;
    if (cv >= 0) tk_read(lds + TK_STAGE + (tk.boff ^ 16384), wid, lane, f);
    if (tk.next < TK_ITEMS) { tk_stage(tk, lds + TK_STAGE + tk.boff, tk.next, wid, lane); tk.sa = tk.next; tk.next += tk.step; } else tk.sa = -1;
    tk.boff ^= 16384;
    return cv;
}
DI void tk_drain(const Args& a, LAS unsigned char* lds, Trickle& tk, int wid, int lane) {
    for (;;) {
        float f[8] = {0.f, 0.f, 0.f, 0.f, 0.f, 0.f, 0.f, 0.f};
        if (tk.sa >= 0) { tk_read(lds + TK_STAGE + (tk.boff ^ 16384), wid, lane, f); tk_store(a, tk.sa, wid, lane, f); }
        if (tk.next >= TK_ITEMS) break;
        tk_stage(tk, lds + TK_STAGE + tk.boff, tk.next, wid, lane); tk.sa = tk.next; tk.next += tk.step; tk.boff ^= 16384;
        WAIT_VM0(); __syncthreads();
    }
}
#define MFMA16(a, b, c) __builtin_amdgcn_mfma_f32_16x16x32_bf16((a), (b), (c), 0, 0, 0)
DI void attn_unit(const Args& a, LAS unsigned char* lds, int bh, int qb, Trickle& tk) {
    const int tid = tidx(), lane = tid & 63, wid = __builtin_amdgcn_readfirstlane(tid >> 6), r = lane & 15, g = lane >> 4;
    bh = __builtin_amdgcn_readfirstlane(bh); qb = __builtin_amdgcn_readfirstlane(qb);
    const int b = bh >> 3, h = bh & 7;
    const bf16_t* Qg = (const bf16_t*)(a.ws + WS_Q); const bf16_t* Kg = (const bf16_t*)(a.ws + WS_K); const bf16_t* Vg = (const bf16_t*)(a.ws + WS_V); bf16_t* OB = (bf16_t*)(a.ws + WS_OB);
    const size_t rowb = (size_t)b * SEQ; const int q0 = qb * 256;
    const int NT = 4 * qb + 4, cw = 4 * qb + (wid >> 1);
    const unsigned char* ksrc = (const unsigned char*)(Kg + (size_t)bh * 128 * 12288);
    const unsigned char* vsrc = (const unsigned char*)(Vg + (size_t)bh * 128 * 8192);
    const unsigned dmo = (unsigned)(wid * 1024 + lane * 16);
#define ATT_DMA(t, slot) do {        \
        _Pragma("unroll") for (int i_ = 0; i_ < 3; ++i_) { unsigned d_ = dmo; unsigned po_ = 8192u * i_; asm volatile("" : "+v"(d_), "+s"(po_)); GLDS16(ksrc + ((size_t)(t) * 24576 + po_) + d_, lds + AT_K + (slot) * 24576 + (wid + 8 * i_) * 1024); } \
        _Pragma("unroll") for (int i_ = 0; i_ < 2; ++i_) { unsigned d_ = dmo; unsigned po_ = 8192u * i_; asm volatile("" : "+v"(d_), "+s"(po_)); GLDS16(vsrc + ((size_t)(t) * 16384 + po_) + d_, lds + AT_V + (slot) * 16384 + (wid + 8 * i_) * 1024); } } while (0)
    ATT_DMA(0, 0);
    if (NT > 1) ATT_DMA(1, 1);
    bf16x8 qf[2][6];
    { const bf16_t* qp = Qg + (rowb + q0 + 32 * wid + r) * 1536 + h * 192 + 8 * g;
#pragma unroll
      for (int qq = 0; qq < 2; ++qq)
#pragma unroll
          for (int ks = 0; ks < 6; ++ks) qf[qq][ks] = *(const bf16x8*)(qp + (size_t)qq * 16 * 1536 + 32 * ks);
#pragma unroll
      for (int qq = 0; qq < 2; ++qq)
#pragma unroll
          for (int ks = 0; ks < 6; ++ks) asm volatile("" : "+v"(qf[qq][ks])); }
    f32x4 o[2][8];
#pragma unroll
    for (int qq = 0; qq < 2; ++qq)
#pragma unroll
        for (int d = 0; d < 8; ++d) o[qq][d] = (f32x4){0.f, 0.f, 0.f, 0.f};
    float mrun[2] = {0.f, 0.f}, lrun[2] = {0.f, 0.f};
    const unsigned krd = (unsigned)(g * 1024 + r * 16);
    const unsigned vrd = (unsigned)((4 * g + (r >> 2)) * 32 + (r & 3) * 8);
    if (NT > 1) asm volatile("s_waitcnt vmcnt(5)" ::: "memory"); else WAIT_VM0();
    RAW_BAR();
    int s0 = 0, s1 = 1, s2 = 2;
    for (int t = 0; t < NT; ++t) {
        bf16x8 kf[3][4];
        LAS const unsigned char* kb = lds + AT_K + s0 * 24576 + krd;
#define ATT_KLD(ks_) do { _Pragma("unroll") for (int kvb = 0; kvb < 4; ++kvb) kf[(ks_) % 3][kvb] = *(const LAS bf16x8*)(kb + (ks_) * 4096 + kvb * 256); } while (0)
        if (t <= cw) { ATT_KLD(0); ATT_KLD(1); }
        __builtin_amdgcn_sched_barrier(0);
        float tf[8] = {0.f, 0.f, 0.f, 0.f, 0.f, 0.f, 0.f, 0.f};
        const int tcv = tk_step(lds, tk, wid, lane, tf);
        if (t + 2 < NT) ATT_DMA(t + 2, s2);
        asm volatile("" : "+v"(tf[0]), "+v"(tf[1]), "+v"(tf[2]), "+v"(tf[3]), "+v"(tf[4]), "+v"(tf[5]), "+v"(tf[6]), "+v"(tf[7]));
        if (tcv >= 0) tk_store(a, tcv, wid, lane, tf);
        if (t <= cw) {
            LAS const unsigned char* vbuf = lds + AT_V + s0 * 16384 + vrd;
            f32x4 sT[4][2];
#pragma unroll
            for (int kvb = 0; kvb < 4; ++kvb)
#pragma unroll
                for (int qq = 0; qq < 2; ++qq) sT[kvb][qq] = (f32x4){-mrun[qq], -mrun[qq], -mrun[qq], -mrun[qq]};
            {
                __builtin_amdgcn_sched_barrier(0);
#pragma unroll
                for (int ks = 0; ks < 6; ++ks) {
                    if (ks + 2 < 6) ATT_KLD(ks + 2);
#pragma unroll
                    for (int kvb = 0; kvb < 4; ++kvb)
#pragma unroll
                        for (int qq = 0; qq < 2; ++qq) sT[kvb][qq] = MFMA16(kf[ks % 3][kvb], qf[qq][ks], sT[kvb][qq]);
                }
#pragma unroll
                for (int i = 0; i < 4; ++i) { __builtin_amdgcn_sched_group_barrier(0x100, 4, 0); __builtin_amdgcn_sched_group_barrier(0x008, 8, 0); }
#pragma unroll
                for (int i = 0; i < 2; ++i) __builtin_amdgcn_sched_group_barrier(0x008, 8, 0);
                __builtin_amdgcn_sched_barrier(0);
            }
            s16x4 vlo[4], vhi[4];
            const unsigned va = (unsigned)(size_t)vbuf;
#define ATT_VLD(i_) do { \
                    asm volatile("ds_read_b64_tr_b16 %0, %1 offset:%2" : "=v"(vlo[(i_) & 3]) : "v"(va), "n"(((i_) & 7) * 2048 + ((i_) >> 3) * 1024) : "memory"); \
                    asm volatile("ds_read_b64_tr_b16 %0, %1 offset:%2" : "=v"(vhi[(i_) & 3]) : "v"(va), "n"(((i_) & 7) * 2048 + ((i_) >> 3) * 1024 + 512) : "memory"); } while (0)
            ATT_VLD(0); ATT_VLD(1); ATT_VLD(2);
            asm volatile("s_nop 15\n\ts_nop 7" : "+v"(sT[0][0]), "+v"(sT[0][1]), "+v"(sT[1][0]), "+v"(sT[1][1]), "+v"(sT[2][0]), "+v"(sT[2][1]), "+v"(sT[3][0]), "+v"(sT[3][1]));
            float mx[2];
#pragma unroll
            for (int qq = 0; qq < 2; ++qq) {
                float m0 = max3f(sT[0][qq][0], sT[0][qq][1], sT[0][qq][2]), m1 = max3f(sT[0][qq][3], sT[1][qq][0], sT[1][qq][1]);
                m0 = max3f(m0, sT[1][qq][2], sT[1][qq][3]); m1 = max3f(m1, sT[2][qq][0], sT[2][qq][1]);
                m0 = max3f(m0, sT[2][qq][2], sT[2][qq][3]); m1 = max3f(m1, sT[3][qq][0], sT[3][qq][1]);
                m0 = max3f(m0, sT[3][qq][2], sT[3][qq][3]); m0 = fmaxf(m0, m1);
                { auto r16 = __builtin_amdgcn_permlane16_swap(__float_as_uint(m0), __float_as_uint(m0), false, false); m0 = fmaxf(__uint_as_float(r16[0]), __uint_as_float(r16[1])); }
                { auto r32 = __builtin_amdgcn_permlane32_swap(__float_as_uint(m0), __float_as_uint(m0), false, false); m0 = fmaxf(__uint_as_float(r32[0]), __uint_as_float(r32[1])); }
                mx[qq] = m0; }
            if (t == 0 || __any(mx[0] > 8.f || mx[1] > 8.f)) {
#pragma unroll
                for (int qq = 0; qq < 2; ++qq) {
                    const float dl = (t == 0) ? mx[qq] : fmaxf(mx[qq], 0.f);
                    mrun[qq] += dl;
#pragma unroll
                    for (int kvb = 0; kvb < 4; ++kvb) sT[kvb][qq] = sT[kvb][qq] - dl;
                    if (t != 0) {
                        const float alpha = __builtin_amdgcn_exp2f(-dl);
                        lrun[qq] *= alpha;
#pragma unroll
                        for (int i = 0; i < 4; ++i) { const float ar = __shfl(alpha, 4 * g + i);
#pragma unroll
                            for (int d = 0; d < 8; ++d) o[qq][d][i] *= ar; }
                    }
                }
            }
            bf16x8 pa[2][2];
#pragma unroll
            for (int qq = 0; qq < 2; ++qq) {
                float ps0 = 0.f, ps1 = 0.f;
#pragma unroll
                for (int kvb = 0; kvb < 4; ++kvb) {
#pragma unroll
                    for (int i = 0; i < 4; ++i) sT[kvb][qq][i] = __builtin_amdgcn_exp2f(sT[kvb][qq][i]);
                    ps0 += sT[kvb][qq][0] + sT[kvb][qq][1]; ps1 += sT[kvb][qq][2] + sT[kvb][qq][3]; }
                lrun[qq] += ps0 + ps1;
#pragma unroll
                for (int s = 0; s < 2; ++s) pa[qq][s] = pack8(sT[2 * s][qq][0], sT[2 * s][qq][1], sT[2 * s][qq][2], sT[2 * s][qq][3], sT[2 * s + 1][qq][0], sT[2 * s + 1][qq][1], sT[2 * s + 1][qq][2], sT[2 * s + 1][qq][3]);
            }
            {
                __builtin_amdgcn_sched_barrier(0);
#pragma unroll
                for (int i = 0; i < 16; ++i) {
                    if (i + 3 < 16) ATT_VLD(i + 3);
                    if (i <= 12) asm volatile("s_waitcnt lgkmcnt(6)" : "+v"(vlo[i & 3]), "+v"(vhi[i & 3]));
                    else if (i == 13) asm volatile("s_waitcnt lgkmcnt(4)" : "+v"(vlo[i & 3]), "+v"(vhi[i & 3]));
                    else if (i == 14) asm volatile("s_waitcnt lgkmcnt(2)" : "+v"(vlo[i & 3]), "+v"(vhi[i & 3]));
                    else asm volatile("s_waitcnt lgkmcnt(0)" : "+v"(vlo[i & 3]), "+v"(vhi[i & 3]));
                    const s16x4 lo = vlo[i & 3], hi = vhi[i & 3];
                    const bf16x8 vf = {lo[0], lo[1], lo[2], lo[3], hi[0], hi[1], hi[2], hi[3]};
                    o[0][i & 7] = MFMA16(pa[0][i >> 3], vf, o[0][i & 7]); o[1][i & 7] = MFMA16(pa[1][i >> 3], vf, o[1][i & 7]);
                    __builtin_amdgcn_sched_barrier(0);
                }
#undef ATT_VLD
            }
        }
#undef ATT_KLD
        if (t + 2 < NT) asm volatile("s_waitcnt vmcnt(5)" ::: "memory"); else WAIT_VM0();
        RAW_BAR();
        { const int tmp = s0; s0 = s1; s1 = s2; s2 = tmp; }
    }
#undef ATT_DMA
    bf16_t* op = OB + (rowb + q0 + 32 * wid) * DM + h * 128 + r;
#pragma unroll
    for (int qq = 0; qq < 2; ++qq) {
        float lt = lrun[qq]; lt += __shfl_xor(lt, 16); lt += __shfl_xor(lt, 32);
        const float inv = 1.f / lt;
#pragma unroll
        for (int i = 0; i < 4; ++i) { const float ir = __shfl(inv, 4 * g + i);
#pragma unroll
            for (int d = 0; d < 8; ++d) op[(size_t)(16 * qq + 4 * g + i) * DM + 16 * d] = f2bf(o[qq][d][i] * ir); }
    }
}

DI void gated_norm_pass(const Args& a) {
    const int lane = tidx() & 63, gw = blockIdx.x * 8 + (tidx() >> 6), NGW = gridDim.x * 8;
    const bf16_t* OA = (const bf16_t*)(a.ws + WS_OA); const bf16_t* proj = (const bf16_t*)(a.ws + WS_PROJ); bf16_t* AA = (bf16_t*)(a.ws + WS_AA);
    float wv[16];
#pragma unroll
    for (int e = 0; e < 16; ++e) wv[e] = a.in[I_GNW][(16 * lane + e) & 127];
    for (int row = gw; row < T_TOK; row += NGW) {
        const u32x4 oa = __builtin_nontemporal_load((const u32x4*)(OA + (size_t)row * DM + 16 * lane)), ob = __builtin_nontemporal_load((const u32x4*)(OA + (size_t)row * DM + 16 * lane + 8));
        const u32x4 za = __builtin_nontemporal_load((const u32x4*)(proj + (size_t)row * NP + C_Z + 16 * lane)), zb = __builtin_nontemporal_load((const u32x4*)(proj + (size_t)row * NP + C_Z + 16 * lane + 8));
        const unsigned ow[8] = {oa.x, oa.y, oa.z, oa.w, ob.x, ob.y, ob.z, ob.w}, zw[8] = {za.x, za.y, za.z, za.w, zb.x, zb.y, zb.z, zb.w};
        float ov[16], zv[16]; float ss = 0.f;
#pragma unroll
        for (int q = 0; q < 8; ++q) { ov[2 * q] = bflo(ow[q]); ov[2 * q + 1] = bfhi(ow[q]); zv[2 * q] = bflo(zw[q]); zv[2 * q + 1] = bfhi(zw[q]); ss += ov[2 * q] * ov[2 * q] + ov[2 * q + 1] * ov[2 * q + 1]; }
        ss += __shfl_xor(ss, 1); ss += __shfl_xor(ss, 2); ss += __shfl_xor(ss, 4);
        const float rs = rsqrtf(ss * (1.f / 128.f) + EPS);
        unsigned w[8];
#pragma unroll
        for (int q = 0; q < 8; ++q) { const float z0 = zv[2 * q], z1 = zv[2 * q + 1]; w[q] = pk2(ov[2 * q] * rs * wv[2 * q] * (z0 * sigmoidf_(z0)), ov[2 * q + 1] * rs * wv[2 * q + 1] * (z1 * sigmoidf_(z1))); }
        const u32x4 wa = {w[0], w[1], w[2], w[3]}, wb = {w[4], w[5], w[6], w[7]};
        *(u32x4*)(AA + (size_t)row * DM + 16 * lane) = wa; *(u32x4*)(AA + (size_t)row * DM + 16 * lane + 8) = wb;
    }
}

constexpr int RT_P = 0, RT_SS = 67584, RT_RS = 69632, RT_HIST = 69888;
DI void router_pass(const Args& a, LAS unsigned char* lds) {
    const int tid = tidx(), lane = tid & 63, wave = __builtin_amdgcn_readfirstlane(tid >> 6), i = lane & 31, kk = lane >> 5;
    LAS float* P = (LAS float*)(lds + RT_P); LAS float* SS = (LAS float*)(lds + RT_SS); LAS float* RS = (LAS float*)(lds + RT_RS); LAS int* hist = (LAS int*)(lds + RT_HIST);
    const float* X1 = (const float*)(a.ws + WS_X1); bf16_t* H2 = (bf16_t*)(a.ws + WS_H2);
    int* TOPI = (int*)(a.ws + WS_TOPI); float* TOPW = (float*)(a.ws + WS_TOPW);
    const float* wffn = a.in[I_NFFN]; const float* br = a.in[I_BR];
    const int kbase = 128 * wave + 64 * kk;
    float bq[64];
    { const float* wr = a.in[I_WR] + (size_t)kbase * 32 + i;
#pragma unroll
      for (int m = 0; m < 64; ++m) bq[m] = wr[m * 32] * wffn[kbase + m]; }
    if (tid < 32) hist[tid] = 0;
    for (int wg = blockIdx.x; wg < T_TOK / 64; wg += gridDim.x) {
#pragma unroll
        for (int rb = 0; rb < 2; ++rb) {
            const float* xr = X1 + (size_t)(wg * 64 + 32 * rb + i) * DM + kbase;
            f32x4 xq[16];
#pragma unroll
            for (int q = 0; q < 16; ++q) xq[q] = *(const f32x4*)(xr + 4 * q);
            f32x16 acc;
#pragma unroll
            for (int r = 0; r < 16; ++r) acc[r] = 0.f;
            float ss = 0.f;
#pragma unroll
            for (int q = 0; q < 16; ++q)
#pragma unroll
                for (int c = 0; c < 4; ++c) { acc = __builtin_amdgcn_mfma_f32_32x32x2f32(xq[q][c], bq[4 * q + c], acc, 0, 0, 0); ss += xq[q][c] * xq[q][c]; }
            ss += __shfl_xor(ss, 32);
            if (kk == 0) SS[wave * 64 + 32 * rb + i] = ss;
#pragma unroll
            for (int r = 0; r < 16; ++r) P[((wave * 2 + rb) * 32 + crow(r, kk)) * 33 + i] = acc[r];
        }
        __syncthreads();
        if (tid < 64) {
            const int rb = tid >> 5, rr = tid & 31, row = wg * 64 + tid;
            float s = 0.f;
#pragma unroll
            for (int w2 = 0; w2 < 8; ++w2) s += SS[w2 * 64 + tid];
            const float rs = rsqrtf(s * (1.f / DM) + EPS);
            RS[tid] = rs;
            float lg[32];
#pragma unroll
            for (int e = 0; e < 32; ++e) { float v = 0.f;
#pragma unroll
                for (int w2 = 0; w2 < 8; ++w2) v += P[((w2 * 2 + rb) * 32 + rr) * 33 + e];
                lg[e] = v * rs + br[e]; }
            int ti[4]; float tv[4];
#pragma unroll
            for (int k = 0; k < 4; ++k) { float best = -INFINITY; int bi = 0;
#pragma unroll
                for (int e = 0; e < 32; ++e) { const bool taken = (k > 0 && ti[0] == e) || (k > 1 && ti[1] == e) || (k > 2 && ti[2] == e); if (!taken && lg[e] > best) { best = lg[e]; bi = e; } }
                ti[k] = bi; tv[k] = best; }
            const float e1 = __expf(tv[1] - tv[0]), e2 = __expf(tv[2] - tv[0]), e3 = __expf(tv[3] - tv[0]); const float inv = 1.f / (1.f + e1 + e2 + e3);
            *(i32x4*)(TOPI + (size_t)row * 4) = (i32x4){ti[0], ti[1], ti[2], ti[3]}; *(f32x4*)(TOPW + (size_t)row * 4) = (f32x4){inv, e1 * inv, e2 * inv, e3 * inv};
            atomicAdd((int*)&hist[ti[0]], 1); atomicAdd((int*)&hist[ti[1]], 1); atomicAdd((int*)&hist[ti[2]], 1); atomicAdd((int*)&hist[ti[3]], 1);
        }
        __syncthreads();
#pragma unroll 8
        for (int j = 0; j < 32; ++j) { const int flat = j * 512 + tid, r = flat >> 8, c4 = flat & 255;
            const f32x4 xv = *(const f32x4*)(X1 + (size_t)(wg * 64 + r) * DM + 4 * c4), wn = *(const f32x4*)(wffn + 4 * c4); const float rs = RS[r];
            constexpr float sc = (float)(1 << pg8::F8_ASHIFT);
            *(unsigned*)((unsigned char*)H2 + (size_t)(wg * 64 + r) * DM + 4 * c4) = pk4_fp8(xv[0] * wn[0] * rs * sc, xv[1] * wn[1] * rs * sc, xv[2] * wn[2] * rs * sc, xv[3] * wn[3] * rs * sc); }
        if (tid < 32) { ((int*)(a.ws + WS_CNT))[wg * 32 + tid] = hist[tid]; hist[tid] = 0; }
        __syncthreads();
    }
}

DI void slot_pass(const Args& a, LAS unsigned char* lds) {
    const int tid = tidx(), lane = tid & 63, wave = tid >> 6;
    LAS int* ptot = (LAS int*)lds;
    LAS int* ppre = ptot + 512;
    LAS int* tot = ppre + 512;
    LAS int* pre = tot + 32;
    LAS int* pstart = pre + 32;
    LAS int* ltopi = pstart + 64;
    LAS int* lslot = ltopi + 256;
    const int* CNT = (const int*)(a.ws + WS_CNT); const int* TOPI = (const int*)(a.ws + WS_TOPI); int* TOKSLOT = (int*)(a.ws + WS_TOKSLOT);
    int* TILEE = (int*)(a.ws + WS_TILEE);
    int* SLOTTOK = (int*)(a.ws + WS_SLOTTOK);
    for (int wg = blockIdx.x; wg < T_TOK / 64; wg += gridDim.x) {
        { const int e = tid & 31, part = tid >> 5; int t = 0, p = 0;
          for (int q = 0; q < 16; ++q) { const int w2 = part * 16 + q; const int c = CNT[w2 * 32 + e]; t += c; if (w2 < wg) p += c; }
          ptot[part * 32 + e] = t; ppre[part * 32 + e] = p; }
        if (tid < 256) ltopi[tid] = TOPI[(size_t)wg * 256 + tid];
        __syncthreads();
        if (tid < 32) { int t = 0, p = 0; for (int q = 0; q < 16; ++q) { t += ptot[q * 32 + tid]; p += ppre[q * 32 + tid]; } tot[tid] = t; pre[tid] = p; }
        __syncthreads();
        if (tid == 0) { int s = 0; for (int e = 0; e < 32; ++e) { pstart[e] = s; s += ((tot[e] + 255) >> 8) << 8; } pstart[32] = s; }
        __syncthreads();
        LAS int* bcnt = lslot + 256;
        int my_e = 0, my_rank = 0;
        if (tid < 256) { my_e = ltopi[tid]; const unsigned long long lt = (1ull << lane) - 1ull;
#pragma unroll 4
            for (int e = 0; e < 32; ++e) { const unsigned long long mk = __ballot(my_e == e); if (my_e == e) my_rank = __popcll(mk & lt); if (lane == 0) bcnt[wave * 32 + e] = __popcll(mk); } }
        __syncthreads();
        if (tid < 256) { int base = pstart[my_e] + pre[my_e]; for (int w2 = 0; w2 < wave; ++w2) base += bcnt[w2 * 32 + my_e]; lslot[tid] = base + my_rank; }
        __syncthreads();
        if (tid < 256) { TOKSLOT[(size_t)wg * 256 + tid] = lslot[tid]; SLOTTOK[lslot[tid]] = wg * 64 + (tid >> 2); }
        if (wg == 0) { const int ntile = pstart[32] >> 8; if (tid == 0) TILEE[511] = ntile;
            for (int t = tid; t < ntile; t += 512) { int e = 0; for (int q = 1; q < 32; ++q) if (t * 256 >= pstart[q]) e = q; TILEE[t] = e; } }
        if (wg == 0) for (int idx = tid; idx < 32 * 256; idx += 512) { const int e = idx >> 8, sl = pstart[e] + tot[e] + (idx & 255); if (sl < pstart[e + 1]) SLOTTOK[sl] = 0; }
        __syncthreads();
    }
}

DI void final_pass(const Args& a) {
    const int lane = tidx() & 63, gw = blockIdx.x * 8 + (tidx() >> 6), NGW = gridDim.x * 8;
    const float* X1 = (const float*)(a.ws + WS_X1); const bf16_t* YS = (const bf16_t*)(a.ws + WS_YS);
    const int* TOKSLOT = (const int*)(a.ws + WS_TOKSLOT); const float* TOPW = (const float*)(a.ws + WS_TOPW);
    f32x4 wv[4];
#pragma unroll
    for (int j = 0; j < 4; ++j) wv[j] = *(const f32x4*)(a.in[I_NFIN] + 256 * j + 4 * lane);
    for (int row = gw; row < T_TOK; row += NGW) {
        f32x4 v[4];
#pragma unroll
        for (int j = 0; j < 4; ++j) v[j] = __builtin_nontemporal_load((const f32x4*)(X1 + (size_t)row * DM + 256 * j + 4 * lane));
#pragma unroll
        for (int k = 0; k < 4; ++k) { const int slot = TOKSLOT[(size_t)row * 4 + k]; const float w = TOPW[(size_t)row * 4 + k];
            const float w8 = w * (1.f / (float)(1 << pg8::F8_YSHIFT));
#pragma unroll
            for (int j = 0; j < 4; ++j) { const unsigned y = __builtin_nontemporal_load((const unsigned*)((const unsigned char*)YS + (size_t)slot * DM + 256 * j + 4 * lane));
                const f32x2 lo = __builtin_amdgcn_cvt_pk_f32_fp8((int)y, false), hi = __builtin_amdgcn_cvt_pk_f32_fp8((int)y, true);
                v[j][0] += w8 * lo[0]; v[j][1] += w8 * lo[1]; v[j][2] += w8 * hi[0]; v[j][3] += w8 * hi[1]; } }
        float s = 0.f;
#pragma unroll
        for (int j = 0; j < 4; ++j) s += (v[j][0] * v[j][0] + v[j][1] * v[j][1]) + (v[j][2] * v[j][2] + v[j][3] * v[j][3]);
        const float rs = rsqrtf(wave_sum(s) * (1.f / DM) + EPS);
#pragma unroll
        for (int j = 0; j < 4; ++j) __builtin_nontemporal_store(v[j] * rs * wv[j], (f32x4*)(a.out + (size_t)row * DM + 256 * j + 4 * lane));
    }
}


#define XB_TMO      128
#define XB_XCNT(j)  (256  + 64 * (j))
#define XB_XSUB(j)  (1280 + 64 * (j))
#define XB_XGEN(j)  (2304 + 64 * (j))
#define XB_TOP      3328
#define XB_TOPGEN   3392
#define XCD_BAR_WORDS 3456
#define XB_SPIN_CAP (1u << 20)
constexpr int CW_BAR = 4096;
constexpr int LDS_MISC = 162816;
DI unsigned xb_ld(unsigned* p)              { return __hip_atomic_load(p, __ATOMIC_RELAXED, __HIP_MEMORY_SCOPE_AGENT); }
DI unsigned xb_add(unsigned* p, unsigned v) { return __hip_atomic_fetch_add(p, v, __ATOMIC_RELAXED, __HIP_MEMORY_SCOPE_AGENT); }
DI unsigned xb_xcc_id() { return (unsigned)__builtin_amdgcn_s_getreg((3 << 11) | 20) & 0xFu; }
#define XB_SPIN(cond, bar) do { unsigned _sp = 0; while (cond) { __builtin_amdgcn_s_sleep(1); \
    if ((++_sp & 255u) == 0u) { if (xb_ld(&(bar)[XB_TMO])) break; if (_sp > XB_SPIN_CAP) { atomicAdd(&(bar)[XB_TMO], 1u); break; } } } } while (0)
struct XcdBarrier { unsigned* bar; unsigned x; volatile LAS unsigned* st; };
DI XcdBarrier xcd_barrier_post(unsigned* bar, volatile LAS unsigned* st) {
    XcdBarrier b; b.bar = bar; b.x = xb_xcc_id(); b.st = st;
    if (threadIdx_x_raw() == 0) (void)xb_add(&bar[XB_XCNT(b.x)], 1u);
    return b;
}
DI void xcd_barrier_complete(unsigned* bar, unsigned x, unsigned& nloc, unsigned& nx) {
    const unsigned G = gridDim.x * gridDim.y * gridDim.z;
    unsigned sum, cnt, mine, sp = 0u;
    for (;;) {
        sum = 0u; cnt = 0u; mine = 0u;
#pragma unroll
        for (unsigned j = 0; j < 16; ++j) { const unsigned c = xb_ld(&bar[XB_XCNT(j)]); sum += c; cnt += (c > 0u) ? 1u : 0u; mine = (j == x) ? c : mine; }
        if (sum == G) break;
        __builtin_amdgcn_s_sleep(1);
        if ((++sp & 255u) == 0u) { if (xb_ld(&bar[XB_TMO])) break; if (sp > XB_SPIN_CAP) { atomicAdd(&bar[XB_TMO], 1u); break; } }
    }
    nloc = mine > 0u ? mine : 1u; nx = cnt > 0u ? cnt : 1u;
}
DI void xcd_barrier(const XcdBarrier& b) {
    asm volatile("s_waitcnt vmcnt(0)" ::: "memory");
    __syncthreads();
    if (threadIdx_x_raw() == 0) {
        unsigned* bar = b.bar;
        __builtin_amdgcn_s_waitcnt(0);
        unsigned nloc = b.st[0], nx = b.st[1];
        if (nloc == 0u) { xcd_barrier_complete(bar, b.x, nloc, nx); b.st[0] = nloc; b.st[1] = nx; }
        const unsigned old = xb_add(&bar[XB_XSUB(b.x)], 1u);
        const unsigned gen = old / nloc;
        if (old + 1u == (gen + 1u) * nloc) {
            __builtin_amdgcn_fence(__ATOMIC_RELEASE, "agent");
            asm volatile("s_waitcnt vmcnt(0)" ::: "memory");
            const unsigned og = xb_add(&bar[XB_TOP], 1u);
            const unsigned tg = og / nx;
            if (og + 1u == (tg + 1u) * nx) xb_add(&bar[XB_TOPGEN], 1u);
            else XB_SPIN(xb_ld(&bar[XB_TOPGEN]) == tg, bar);
            __builtin_amdgcn_fence(__ATOMIC_ACQUIRE, "agent");
            xb_add(&bar[XB_XGEN(b.x)], 1u);
            asm volatile("s_waitcnt vmcnt(0)" ::: "memory");
        } else {
            XB_SPIN(xb_ld(&bar[XB_XGEN(b.x)]) == gen, bar);
            __builtin_amdgcn_fence(__ATOMIC_ACQUIRE, "agent");
            asm volatile("s_waitcnt vmcnt(0)" ::: "memory");
        }
    }
    __syncthreads();
}

constexpr int NPH = 12;
#ifndef PROBE_REP
#define PROBE_REP {1,1,1,1,1,1,1,1,1,1,1,1}
#endif
constexpr int REP[NPH] = PROBE_REP;
template <bool COOP>
__global__ void __launch_bounds__(512, 2) mega(Args a_by_value) {
    const Args& a = *(const Args*)(const __attribute__((address_space(4))) Args*)__builtin_amdgcn_kernarg_segment_ptr();
    extern __shared__ __attribute__((aligned(16))) unsigned char lds_raw[];
    LAS unsigned char* lds = (LAS unsigned char*)lds_raw;
    const int lo = a.ph_lo, hi = a.ph_hi;
    const int G = gridDim.x, bx = blockIdx.x;
    unsigned char* ws = a.ws;
#define IN(k) (lo <= (k) && (k) < hi)
    XcdBarrier gbar; gbar.bar = (unsigned*)(ws + WS_CTL) + CW_BAR; gbar.x = 0; gbar.st = (volatile LAS unsigned*)(lds + LDS_MISC);
    if (COOP) { if (tidx() < 2) ((LAS unsigned*)(lds + LDS_MISC))[tidx()] = 0u; __syncthreads(); gbar = xcd_barrier_post((unsigned*)(ws + WS_CTL) + CW_BAR, (volatile LAS unsigned*)(lds + LDS_MISC)); }
#define SYNC(k) do { if (COOP && IN(k) && IN((k) + 1)) { xcd_barrier(gbar); } } while (0)
    if (IN(0)) for (int rep_ = 0; rep_ < REP[0]; ++rep_) { phase_prologue(a, lds); }
    SYNC(0);
    if (IN(1)) for (int rep_ = 0; rep_ < REP[1]; ++rep_) {
        pg8::DenseSched S{(const char*)(ws + WS_XN), (const char*)(ws + WS_WIN), (size_t)256 * DM * 2, (size_t)256 * DM * 2, T_TOK / 256, NP / 256, G, bx};
        pg8::EpiProj E{(bf16_t*)(ws + WS_PROJ), (float*)(ws + WS_SSQQ), (float*)(ws + WS_SSQKV)};
        pg8::gemm_phase(lds, DM, DM, DM, S, E);
    }
    SYNC(1);
    if (IN(2)) for (int rep_ = 0; rep_ < REP[2]; ++rep_) {
#ifndef PROBE_PREP_REP
#define PROBE_PREP_REP 1
#endif
        for (int pr_ = 0; pr_ < PROBE_PREP_REP; ++pr_) {
            u32x4 xr[3][5];
            const bool wgm = (2048 % G) == 0; const int per = wgm ? 2048 / G : 0;
            const int u0 = wgm ? bx * per : bx, ustep = wgm ? 1 : G, uend = wgm ? (bx + 1) * per : 2048;
            if (u0 < uend) gdn_prep_load(a, u0 >> 7, u0 & 127, tidx(), xr);
            int hprev = -1;
            for (int u = u0; u < uend; u += ustep) { const int un = u + ustep; const int hcur = (u >> 7) & 7;
                gdn_prep_unit(a, lds, u >> 7, u & 127, xr, un < uend ? (un >> 7) : -1, un & 127, hcur != hprev); hprev = hcur; }
            __syncthreads();
        }
#ifndef PROBE_P2G_REP
#define PROBE_P2G_REP 1
#endif
        for (int pg_ = 0; pg_ < PROBE_P2G_REP; ++pg_) {
        krope_pass(a);
        { pg8::QKVSched S{(const char*)(ws + WS_PROJ) + C_CQ * 2, (const char*)(ws + WS_WQB), (const char*)(ws + WS_PROJ) + C_CKV * 2, (const char*)(ws + WS_WKVB), G, bx};
          pg8::EpiQKV E{pg8::EpiQ{(bf16_t*)(ws + WS_Q), (const float*)(ws + WS_SSQQ), (const f32x2*)(ws + WS_ROPE)}, pg8::EpiKV{(bf16_t*)(ws + WS_K), (bf16_t*)(ws + WS_V), (const float*)(ws + WS_SSQKV)}};
          pg8::gemm_phase(lds, NP, 512, 512, S, E); }
        }
    }
    SYNC(2);
    if (IN(3)) for (int rep_ = 0; rep_ < REP[3]; ++rep_) {
#ifndef PROBE_SCAN_REP
#define PROBE_SCAN_REP 1
#endif
        for (int sr_ = 0; sr_ < PROBE_SCAN_REP; ++sr_)
        if (bx < 16) gdn_scan_wg(a, lds, bx);
        __syncthreads();
        unsigned* ctr = (unsigned*)(ws + WS_CTL) + 64 * rep_;
        LAS int* su = (LAS int*)(lds + LDS_MISC + 64);
        Trickle tk; { const int nsc = G > 16 ? 16 : 0; tk.step = G - nsc; tk.next = bx >= nsc ? bx - nsc : TK_ITEMS; tk.sa = -1; tk.boff = 0; tk.wgu = a.in[I_WGU]; tk.wd = a.in[I_WD]; }
        for (;;) {
            if (tidx() == 0) su[0] = (int)atomicAdd(ctr, 1u);
            __syncthreads();
            const int u = su[0];
            __syncthreads();
            if (u >= 512) break;
            attn_unit(a, lds, u & 15, 31 - (u >> 4), tk);
        }
        tk_drain(a, lds, tk, __builtin_amdgcn_readfirstlane(tidx() >> 6), tidx() & 63);
    }
    SYNC(3);
    if (IN(4)) for (int rep_ = 0; rep_ < REP[4]; ++rep_) { gated_norm_pass(a); }
    SYNC(4);
    if (IN(5)) for (int rep_ = 0; rep_ < REP[5]; ++rep_) {
        { pg8::PairSched S{(const char*)(ws + WS_AA), (const char*)(ws + WS_WGDNO), (const char*)(ws + WS_OB), (const char*)(ws + WS_WMLAO), (size_t)256 * DM * 2, (size_t)256 * DM * 2, T_TOK / 256, DM / 256, G, bx};
          pg8::EpiMerge E{(bf16_t*)(ws + WS_MG), (const bf16_t*)(ws + WS_PROJ)};
          pg8::gemm_phase(lds, DM, DM, DM, S, E); }
    }
    SYNC(5);
    if (IN(6)) for (int rep_ = 0; rep_ < REP[6]; ++rep_) {
        pg8::DenseSched S{(const char*)(ws + WS_MG), (const char*)(ws + WS_WOUT), (size_t)256 * DM * 2, (size_t)256 * DM * 2, T_TOK / 256, DM / 256, G, bx};
        pg8::EpiRes E{a.in[I_X], (float*)(ws + WS_X1)};
        pg8::gemm_phase(lds, DM, DM, DM, S, E);
    }
    SYNC(6);
    if (IN(7)) for (int rep_ = 0; rep_ < REP[7]; ++rep_) { router_pass(a, lds); }
    SYNC(7);
    if (IN(8)) for (int rep_ = 0; rep_ < REP[8]; ++rep_) { slot_pass(a, lds); }
    SYNC(8);
    if (IN(9)) for (int rep_ = 0; rep_ < REP[9]; ++rep_) {
        const int* TILEE = (const int*)(ws + WS_TILEE);
        const int nT = TILEE[511];
        LAS int* tokmap = (LAS int*)(lds + 131072); LAS int* ue = tokmap + 14 * 256;
        { const int* SLOTTOK = (const int*)(ws + WS_SLOTTOK); const int t = tidx();
          if (t < 256) { int tv[14];
#pragma unroll
              for (int i = 0; i < 14; ++i) { int pm, pn; const bool ok = pg8::tile_of(i, G, bx, nT, 8, pm, pn); tv[i] = SLOTTOK[(ok ? pm : 0) * 256 + t]; }
#pragma unroll
              for (int i = 0; i < 14; ++i) tokmap[i * 256 + t] = tv[i]; }
          else if (t < 256 + 14) { int pm, pn; const bool ok = pg8::tile_of(t - 256, G, bx, nT, 8, pm, pn); ue[t - 256] = ok ? TILEE[pm] : 0; }
          __syncthreads(); }
        pg8::MoeSched S{(const char*)(ws + WS_H2), (const char*)(ws + WS_WGU), (size_t)0, (size_t)256 * DM, (size_t)2048 * 1024, ue, nT, 8, G, bx};
        pg8::EpiGU E{(bf16_t*)(ws + WS_ACT), a.in[I_BGU]};
        pg8::gemm_phase<pg8::EpiGU, pg8::MoeSched, true, true>(lds, DM / 2, DM / 2, DM / 2, S, E, tokmap);
    }
    SYNC(9);
    if (IN(10)) for (int rep_ = 0; rep_ < REP[10]; ++rep_) {
        const int* TILEE = (const int*)(ws + WS_TILEE);
        const int nT = TILEE[511];
        LAS int* ue = (LAS int*)(lds + 131072) + 14 * 256;
        { const int t = tidx(); if (t < 14) { int pm, pn; const bool ok = pg8::tile_of(t, G, bx, nT, 4, pm, pn); ue[t] = ok ? TILEE[pm] : 0; } __syncthreads(); }
        pg8::MoeSched S{(const char*)(ws + WS_ACT), (const char*)(ws + WS_WD), (size_t)256 * DM, (size_t)256 * DM, (size_t)1024 * 1024, ue, nT, 4, G, bx};
        pg8::EpiDown E{(bf16_t*)(ws + WS_YS), a.in[I_BD]};
        pg8::gemm_phase<pg8::EpiDown, pg8::MoeSched, false, true>(lds, DM / 2, DM / 2, DM / 2, S, E);
    }
    SYNC(10);
    if (IN(11)) for (int rep_ = 0; rep_ < REP[11]; ++rep_) { final_pass(a); }
#undef IN
#undef SYNC
}

#ifndef N_LAUNCH_MODE
#define N_LAUNCH_MODE 1
#endif
extern "C" void kernel_launch(void* const* d_in, const int* in_sizes, int n_in, void* d_out, int out_size, void* d_ws, size_t ws_size, hipStream_t stream) {
    static int grid = 0;
    if (grid == 0) {
        if (n_in != 22 || out_size != T_TOK * DM || ws_size < WS_END) { fprintf(stderr, "kernel_launch: unexpected shapes (n_in %d, out %d, ws %zu)\n", n_in, out_size, ws_size); grid = -1; return; }
        int dev = 0, cus = 0, per_cu = 0;
        hipGetDevice(&dev); hipDeviceGetAttribute(&cus, hipDeviceAttributeMultiprocessorCount, dev);
        hipFuncSetAttribute((const void*)mega<false>, hipFuncAttributeMaxDynamicSharedMemorySize, LDS_BYTES);
        hipFuncSetAttribute((const void*)mega<true>, hipFuncAttributeMaxDynamicSharedMemorySize, LDS_BYTES);
        hipOccupancyMaxActiveBlocksPerMultiprocessor(&per_cu, (const void*)mega<true>, 512, LDS_BYTES);
        (void)hipGetLastError();
        if (per_cu < 1) per_cu = 1;
        grid = cus;
        if (grid > 256) grid = 256;
    }
    if (grid < 0) return;
    hipMemsetAsync((char*)d_ws + WS_CTL, 0, CTL_BYTES, stream);
    Args a{};
    for (int i = 0; i < 22; ++i) a.in[i] = (const float*)d_in[i];
    a.out = (float*)d_out; a.ws = (unsigned char*)d_ws;
#if N_LAUNCH_MODE == 1
    a.ph_lo = 0; a.ph_hi = NPH;
    void* args[] = {&a};
    hipError_t e = hipLaunchCooperativeKernel((const void*)mega<true>, dim3(grid), dim3(512), args, LDS_BYTES, stream);
    if (e != hipSuccess) fprintf(stderr, "cooperative launch failed: %s (grid %d)\n", hipGetErrorString(e), grid);
#else
    for (int p = 0; p < NPH; ++p) { a.ph_lo = p; a.ph_hi = p + 1; hipLaunchKernelGGL(mega<false>, dim3(grid), dim3(512), LDS_BYTES, stream, a); }
#endif
}
```

```cpp
#include <hip/hip_runtime.h>
#include <hip/hip_cooperative_groups.h>
#include <cstdio>
#include <cstdint>
namespace cg = cooperative_groups;

#define DI __device__ __forceinline__
#define LAS __attribute__((address_space(3)))
typedef unsigned short bf16_t;
typedef short bf16x8 __attribute__((ext_vector_type(8)));
typedef short s16x4 __attribute__((ext_vector_type(4)));
typedef float f32x2 __attribute__((ext_vector_type(2)));
typedef float f32x4 __attribute__((ext_vector_type(4)));
typedef float f32x16 __attribute__((ext_vector_type(16)));
typedef unsigned u32x2 __attribute__((ext_vector_type(2)));
typedef unsigned u32x4 __attribute__((ext_vector_type(4)));
typedef int i32x4 __attribute__((ext_vector_type(4)));
typedef __bf16 bf16x2_t __attribute__((ext_vector_type(2)));

constexpr int T_TOK = 16384, SEQ = 8192, DM = 1024;
constexpr int NP = 7168;
constexpr int C_Q = 0, C_K = 1024, C_V = 2048, C_Z = 3072, C_GA = 4096, C_GB = 5120, C_CQ = 6144, C_CKV = 6656, C_KR = 6912, C_BG = 6976, C_AG = 6984;
constexpr int NEXP = 32;
constexpr float EPS = 1e-6f;
constexpr float QSCALE = 0.10411754627697264f;

constexpr size_t MiB = 1u << 20;
constexpr size_t WS_CTL = 0, CTL_BYTES = 32768;
constexpr size_t WS_WIN = 2 * MiB, WS_WGDNO = 16 * MiB, WS_WMLAO = 18 * MiB, WS_WOUT = 20 * MiB, WS_WQB = 22 * MiB, WS_WKVB = 24 * MiB, WS_ROPE = 26 * MiB;
constexpr size_t WS_SSQQ = 28 * MiB, WS_SSQKV = 28 * MiB + 512 * 1024, WS_GLAST = 29 * MiB, WS_TOPI = 29 * MiB + 512 * 1024, WS_TOPW = 30 * MiB, WS_TOKSLOT = 30 * MiB + 512 * 1024,
                 WS_CNT = 31 * MiB, WS_TILEE = 31 * MiB + 256 * 1024, WS_SLOTTOK = 31 * MiB + 512 * 1024;
constexpr size_t WS_WGU = 32 * MiB, WS_WD = 160 * MiB, WS_XN = 224 * MiB, WS_PROJ = 256 * MiB, WS_FR = 480 * MiB, WS_Q = 624 * MiB, WS_K = 672 * MiB, WS_V = 720 * MiB,
                 WS_OA = 752 * MiB, WS_OB = 784 * MiB, WS_AA = 816 * MiB, WS_MG = 848 * MiB, WS_X1 = 880 * MiB, WS_END = 944 * MiB;
constexpr size_t WS_H2 = WS_XN, WS_ACT = WS_PROJ, WS_YS = WS_Q;
constexpr int FR_UNIT = 73728, FR_NW = 0, FR_QD = 16384, FR_KD = 32768, FR_QK = 49152, FR_U = 57344;
constexpr int LDS_BYTES = 163840;

DI unsigned pk2(float lo, float hi) { f32x2 v = {lo, hi}; bf16x2_t b = __builtin_convertvector(v, bf16x2_t); return __builtin_bit_cast(unsigned, b); }
DI bf16_t f2bf(float f) { return (bf16_t)(pk2(f, 0.f) & 0xffffu); }
DI float bf2f(bf16_t b) { return __uint_as_float((unsigned)b << 16); }
DI float bflo(unsigned w) { return __uint_as_float(w << 16); }
DI float bfhi(unsigned w) { return __uint_as_float(w & 0xffff0000u); }
DI int threadIdx_x_raw() { return (int)__builtin_amdgcn_workitem_id_x(); }
DI float sigmoidf_(float x) { return __builtin_amdgcn_rcpf(1.f + __expf(-x)); }
DI int tidx() { int t = threadIdx_x_raw(); asm volatile("" : "+v"(t)); return t; }
DI int crow(int r, int h) { return (r & 3) + 8 * (r >> 2) + 4 * h; }
DI float wave_sum(float v) {
#pragma unroll
    for (int o = 1; o < 64; o <<= 1) v += __shfl_xor(v, o);
    return v;
}
#define LDS_WAIT() asm volatile("s_waitcnt lgkmcnt(0)" ::: "memory")
#define RAW_BAR() do { asm volatile("s_waitcnt lgkmcnt(0)" ::: "memory"); __builtin_amdgcn_s_barrier(); asm volatile("" ::: "memory"); } while (0)
#define MFMA32(a, b, c) __builtin_amdgcn_mfma_f32_32x32x16_bf16((a), (b), (c), 0, 0, 0)
DI bf16x8 pack8(float a0, float a1, float a2, float a3, float a4, float a5, float a6, float a7) {
    u32x4 p; p.x = pk2(a0, a1); p.y = pk2(a2, a3); p.z = pk2(a4, a5); p.w = pk2(a6, a7); return __builtin_bit_cast(bf16x8, p);
}
DI bf16x8 pack_step(const f32x16& x, int s) { return pack8(x[8 * s], x[8 * s + 1], x[8 * s + 2], x[8 * s + 3], x[8 * s + 4], x[8 * s + 5], x[8 * s + 6], x[8 * s + 7]); }

namespace pg8 {
constexpr int BM = 256, BK = 64, HALF = 128, HTB = HALF * BK * 2, STAGE_BYTES = 8 * HTB, NXCD = 8, WGM = 8;
__host__ __device__ __forceinline__ int lds_byte(int r, int c) { const int st = (r >> 4) * 2 + (c >> 5), rr = r & 15, cc = c & 31, ob = rr * 64 + cc * 2; return st * 1024 + (ob ^ (((ob >> 9) & 1) << 5)); }
__host__ __device__ __forceinline__ void stage_rc(int b, int& R, int& C) { const int st = b / 1024, sb = b % 1024, swz = sb ^ (((sb >> 9) & 1) << 5); R = (st >> 1) * 16 + swz / 64; C = (st & 1) * 32 + (swz % 64) / 2; }
__host__ __device__ __forceinline__ int perm32(int rho) { const int n = rho >> 4, i = rho & 15; return 8 * (i >> 2) + 4 * n + (i & 3); }

struct Unit { const char* A; const char* B; int pm, pn, aux; };
template <class S, class = void> struct sched_var_k { static constexpr bool value = false; };
template <class S> struct sched_var_k<S, decltype((void)S::VAR_K)> { static constexpr bool value = S::VAR_K; };
template <class E, class = void> struct epi_chain { static constexpr bool value = false; };
template <class E> struct epi_chain<E, decltype((void)E::CHAIN)> { static constexpr bool value = E::CHAIN; };

DI bool tile_of(int i, int G, int c, int nM, int nN, int& pm, int& pn) {
    const int nwg = nM * nN; const long L = (long)i * G + c; if (L >= nwg) return false;
    int wgid = (int)L; { const int q = nwg / NXCD, r = nwg % NXCD, xcd = wgid % NXCD, off = wgid / NXCD; wgid = (xcd < r ? xcd * (q + 1) : r * (q + 1) + (xcd - r) * q) + off; }
    const int nig = WGM * nN, gid = wgid / nig, fm = gid * WGM, gsz = (nM - fm) < WGM ? (nM - fm) : WGM;
    pm = fm + ((wgid % nig) % gsz); pn = (wgid % nig) / gsz; return true;
}
DI void tile_from_L(int L, int nM, int nN, int& pm, int& pn) {
    const int nwg = nM * nN; int wgid = L; { const int q = nwg / NXCD, r = nwg % NXCD, xcd = wgid % NXCD, off = wgid / NXCD; wgid = (xcd < r ? xcd * (q + 1) : r * (q + 1) + (xcd - r) * q) + off; }
    const int nig = WGM * nN, gid = wgid / nig, fm = gid * WGM, gsz = (nM - fm) < WGM ? (nM - fm) : WGM;
    pm = fm + ((wgid % nig) % gsz); pn = (wgid % nig) / gsz;
}
struct DenseSched {
    const char* A; const char* B; size_t atile, btile; int nM, nN, G, c;
    DI bool next(int i, Unit& u) const { int pm, pn; if (!tile_of(i, G, c, nM, nN, pm, pn)) return false; u.pm = pm; u.pn = pn; u.aux = 0; u.A = A + (size_t)pm * atile; u.B = B + (size_t)pn * btile; return true; }
};
struct PairSched {
    const char* A0; const char* B0; const char* A1; const char* B1; size_t atile, btile; int nM, nN, G, c;
    DI bool next(int i, Unit& u) const { int pm, pn; if (!tile_of(i >> 1, G, c, nM, nN, pm, pn)) return false; u.pm = pm; u.pn = pn; u.aux = i & 1;
        u.A = ((i & 1) ? A1 : A0) + (size_t)pm * atile; u.B = ((i & 1) ? B1 : B0) + (size_t)pn * btile; return true; }
};
struct QKVSched {
    static constexpr bool VAR_K = true;
    const char* Aq; const char* Bq; const char* Akv; const char* Bkv; int G, c;
    DI int nt_of(const Unit& u) const { return u.aux ? 4 : 8; }
    DI bool next(int i, Unit& u) const {
        int kind, idx;
        if (G == 256) {
            if (c < 128) { if (i > 2) return false; kind = (i == 2); idx = (i == 0) ? c : (i == 1) ? 256 + c : c; }
            else { if (i > 3) return false; kind = (i > 0); idx = (i == 0) ? c : 128 + 3 * (c - 128) + (i - 1); }
        } else { const int L = i * G + c; if (L >= 896) return false; kind = (L >= 384); idx = kind ? L - 384 : L; }
        int pm, pn; tile_from_L(idx, 64, kind ? 8 : 6, pm, pn);
        u.pm = pm; u.pn = pn; u.aux = kind;
        u.A = (kind ? Akv : Aq) + (size_t)pm * ((size_t)256 * NP * 2); u.B = (kind ? Bkv : Bq) + (size_t)pn * ((size_t)256 * 512 * 2);
        return true;
    }
};
struct MoeSched {
    const char* A; const char* B; size_t atile, btile, ebytes; const int* tile_e; int nM, nN, G, c;
    DI bool next(int i, Unit& u) const { int pm, pn; if (!tile_of(i, G, c, nM, nN, pm, pn)) return false; u.pm = pm; u.pn = pn; const int e = tile_e[pm]; u.aux = e;
        u.A = A + (size_t)pm * atile; u.B = B + (size_t)e * ebytes + (size_t)pn * btile; return true; }
};

typedef int v4i_t __attribute__((ext_vector_type(4)));
typedef int v8i_t __attribute__((ext_vector_type(8)));
DI v8i_t cat8(bf16x8 lo, bf16x8 hi) { const v4i_t a = __builtin_bit_cast(v4i_t, lo), b = __builtin_bit_cast(v4i_t, hi); return __builtin_shufflevector(a, b, 0, 1, 2, 3, 4, 5, 6, 7); }
constexpr int F8_WSHIFT = 6, F8_ASHIFT = 4, F8_CSHIFT = 2, F8_YSHIFT = 4;
constexpr float F8_UNSCALE = 1.f / (float)(1 << (F8_WSHIFT + F8_ASHIFT)), F8_UNSCALE_DOWN = 1.f / (float)(1 << (F8_WSHIFT + F8_CSHIFT));
template <class Epi, class Sched, bool GATHER = false, bool F8 = false>
DI void gemm_phase(LAS unsigned char* lds, const int lda, const int ldb, const int K, const Sched& S, const Epi& E, LAS const int* tokmap = nullptr) {
    const int tid = tidx(), wid = __builtin_amdgcn_readfirstlane(tid >> 6), lane = tid & 63, wr = wid >> 2, wc = wid & 3, fr = lane & 15, fq = lane >> 4;
    const int nt = K / BK;
    unsigned voffB[2];
#pragma unroll
    for (int i = 0; i < 2; ++i) { int R, C; stage_rc(tid * 16 + i * 8192, R, C); const int Rb = Epi::PERM ? ((R & ~31) + perm32(R & 31)) : R;
        voffB[i] = (unsigned)(Rb * ldb + C) * 2u; }
    unsigned gc[2][2], gn[GATHER ? 2 : 1][2];
#define PG8_AOFFS(g, ui_) do { _Pragma("unroll") for (int h_ = 0; h_ < 2; ++h_) _Pragma("unroll") for (int i_ = 0; i_ < 2; ++i_) { int R_, C_; stage_rc(tid * 16 + i_ * 8192, R_, C_); const int r_ = h_ * HALF + R_; \
        const int t_ = GATHER ? tokmap[(ui_) * 256 + r_] : r_; g[h_][i_] = (unsigned)(t_ * lda + C_) * 2u; } } while (0)
    const size_t kstep = (size_t)(BK * 2);
    const size_t hstepA = (size_t)HALF * lda * 2, hstepB = (size_t)HALF * ldb * 2;
#define PG8_STAGE_A(bufoff, base, h, o0, o1) do { if constexpr (GATHER) { if (h) PG8_STAGE(bufoff, base, o1); else PG8_STAGE(bufoff, base, o0); } \
        else { PG8_STAGE(bufoff, (base) + ((h) ? hstepA : (size_t)0), o0); } } while (0)
    const unsigned ldsw = (unsigned)wid * 1024u;
    const int aoff = lds_byte(wr * 64 + fr, fq * 8), boff = lds_byte(wc * 32 + fr, fq * 8);
#define PG8_SA(b, h) (((b) * 2 + (h)) * HTB)
#define PG8_SB(b, h) ((4 + (b) * 2 + (h)) * HTB)
#define PG8_STAGE(bufoff, gbase, voff) do { _Pragma("unroll") for (int _i = 0; _i < 2; ++_i) \
        __builtin_amdgcn_global_load_lds((const unsigned*)((const char*)(gbase) + (voff)[_i]), (LAS unsigned*)(lds + (bufoff) + ldsw + _i * 8192), 16, 0, 0); } while (0)
#define PG8_LDA(dst, b, h) do { if constexpr (F8) { _Pragma("unroll") for (int m = 0; m < 4; ++m) dst##8[m] = cat8(*(const LAS bf16x8*)(lds + PG8_SA(b, h) + aoff + m * 2048), *(const LAS bf16x8*)(lds + PG8_SA(b, h) + aoff + m * 2048 + 1024)); } \
        else { _Pragma("unroll") for (int m = 0; m < 4; ++m) _Pragma("unroll") for (int k = 0; k < 2; ++k) dst[m][k] = *(const LAS bf16x8*)(lds + PG8_SA(b, h) + aoff + m * 2048 + k * 1024); } } while (0)
#define PG8_LDB(dst, b, h) do { if constexpr (F8) { _Pragma("unroll") for (int n = 0; n < 2; ++n) dst##8[n] = cat8(*(const LAS bf16x8*)(lds + PG8_SB(b, h) + boff + n * 2048), *(const LAS bf16x8*)(lds + PG8_SB(b, h) + boff + n * 2048 + 1024)); } \
        else { _Pragma("unroll") for (int n = 0; n < 2; ++n) _Pragma("unroll") for (int k = 0; k < 2; ++k) dst[n][k] = *(const LAS bf16x8*)(lds + PG8_SB(b, h) + boff + n * 2048 + k * 1024); } } while (0)
#define PG8_MMA(ai, bj, At, Bt) do { __builtin_amdgcn_s_setprio(1); \
        if constexpr (F8) { _Pragma("unroll") for (int m = 0; m < 4; ++m) _Pragma("unroll") for (int n = 0; n < 2; ++n) \
            asm volatile("v_mfma_f32_16x16x128_f8f6f4 %0, %1, %2, %0" : "+v"(acc[ai][bj][m][n]) : "v"(Bt##8[n]), "v"(At##8[m])); }   \
        else { _Pragma("unroll") for (int m = 0; m < 4; ++m) _Pragma("unroll") for (int n = 0; n < 2; ++n) _Pragma("unroll") for (int k = 0; k < 2; ++k) \
            acc[ai][bj][m][n] = __builtin_amdgcn_mfma_f32_16x16x32_bf16(Bt[n][k], At[m][k], acc[ai][bj][m][n], 0, 0, 0); } \
        __builtin_amdgcn_s_setprio(0); } while (0)
#define PG8_WAIT_V(n) asm volatile("s_waitcnt vmcnt(" #n ")" ::: "memory")
#define PG8_WAIT_L(n) asm volatile("s_waitcnt lgkmcnt(" #n ")" ::: "memory")
#define PG8_BAR __builtin_amdgcn_s_barrier()
#define PG8_SCHED __builtin_amdgcn_sched_barrier(0)
    Unit cur, nxt; int ui = 0;
    if (!S.next(0, cur)) return;
    f32x4 acc[2][2][4][2];
#pragma unroll
    for (int a = 0; a < 2; ++a)
#pragma unroll
        for (int b = 0; b < 2; ++b)
#pragma unroll
            for (int m = 0; m < 4; ++m)
#pragma unroll
                for (int n = 0; n < 2; ++n) acc[a][b][m][n] = (f32x4){0.f, 0.f, 0.f, 0.f};
    bf16x8 At[4][2], B0[2][2], B1[2][2];
    v8i_t At8[4], B08[2], B18[2];
    const char* cA = cur.A; const char* cB = cur.B;
    PG8_AOFFS(gc, 0);
    PG8_STAGE(PG8_SB(0, 0), cB, voffB); PG8_STAGE(PG8_SB(0, 1), cB + hstepB, voffB); PG8_STAGE_A(PG8_SA(0, 0), cA, 0, gc[0], gc[1]); PG8_STAGE_A(PG8_SA(0, 1), cA, 1, gc[0], gc[1]);
    if (wr == 1) PG8_BAR;
    PG8_WAIT_V(2); PG8_BAR;
    PG8_STAGE(PG8_SB(1, 0), cB + kstep, voffB); PG8_STAGE_A(PG8_SA(1, 0), cA + kstep, 0, gc[0], gc[1]); PG8_STAGE(PG8_SB(1, 1), cB + hstepB + kstep, voffB);
    PG8_WAIT_V(6); PG8_BAR;
    for (;;) {
        const bool has_next = S.next(ui + 1, nxt);
        const char* nA = has_next ? nxt.A : cA; const char* nB = has_next ? nxt.B : cB;
        if constexpr (GATHER) { if (has_next) { PG8_AOFFS(gn, ui + 1); } else {
#pragma unroll
            for (int h_ = 0; h_ < 2; ++h_)
#pragma unroll
                for (int i_ = 0; i_ < 2; ++i_) gn[h_][i_] = gc[h_][i_]; } }
        int ntu = nt; if constexpr (sched_var_k<Sched>::value) ntu = S.nt_of(cur);
#pragma unroll 1
        for (int t = 0; t < ntu; t += 2) {
            const bool last = (t == ntu - 2);
            const char* a1 = cA + (size_t)(t + 1) * kstep;
            const char* a2 = last ? nA : cA + (size_t)(t + 2) * kstep; const char* b2 = last ? nB : cB + (size_t)(t + 2) * kstep;
            const char* a3 = a2 + kstep; const char* b3 = b2 + kstep;
            unsigned g0[2], g1[2];
#pragma unroll
            for (int i_ = 0; i_ < 2; ++i_) { if constexpr (GATHER) { g0[i_] = last ? gn[0][i_] : gc[0][i_]; g1[i_] = last ? gn[1][i_] : gc[1][i_]; } else { g0[i_] = gc[0][i_]; g1[i_] = gc[1][i_]; } }
            PG8_LDB(B0, 0, 0); PG8_LDB(B1, 0, 1); PG8_SCHED; PG8_LDA(At, 0, 0); PG8_STAGE_A(PG8_SA(1, 1), a1, 1, gc[0], gc[1]);
            PG8_WAIT_V(8); PG8_WAIT_L(0); PG8_BAR; PG8_MMA(0, 0, At, B0); PG8_MMA(0, 1, At, B1); PG8_BAR; PG8_SCHED;
            PG8_LDA(At, 0, 1); PG8_STAGE(PG8_SB(0, 0), b2, voffB); PG8_STAGE(PG8_SB(0, 1), b2 + hstepB, voffB); PG8_STAGE_A(PG8_SA(0, 0), a2, 0, g0, g1);
            PG8_WAIT_V(8); PG8_WAIT_L(0); PG8_BAR; PG8_MMA(1, 0, At, B0); PG8_MMA(1, 1, At, B1); PG8_BAR; PG8_SCHED;
            PG8_LDB(B0, 1, 0); PG8_LDB(B1, 1, 1); PG8_SCHED; PG8_LDA(At, 1, 0); PG8_STAGE_A(PG8_SA(0, 1), a2, 1, g0, g1);
            PG8_WAIT_V(8); PG8_WAIT_L(0); PG8_BAR; PG8_MMA(0, 0, At, B0); PG8_MMA(0, 1, At, B1); PG8_BAR; PG8_SCHED;
            PG8_LDA(At, 1, 1); PG8_STAGE(PG8_SB(1, 0), b3, voffB); PG8_STAGE(PG8_SB(1, 1), b3 + hstepB, voffB); PG8_STAGE_A(PG8_SA(1, 0), a3, 0, g0, g1);
            PG8_WAIT_V(8); PG8_WAIT_L(0); PG8_BAR; PG8_MMA(1, 0, At, B0); PG8_MMA(1, 1, At, B1); PG8_BAR; PG8_SCHED;
        }
        if (wr == 0) PG8_BAR;
        if constexpr (F8) asm volatile("s_nop 15\n\ts_nop 15" ::: "memory");
        E(acc, cur, wr, wc, fr, fq);
        if (!has_next) break;
        if (!(epi_chain<Epi>::value && cur.aux == 0)) {
#pragma unroll
        for (int a = 0; a < 2; ++a)
#pragma unroll
            for (int b = 0; b < 2; ++b)
#pragma unroll
                for (int m = 0; m < 4; ++m)
#pragma unroll
                    for (int n = 0; n < 2; ++n) acc[a][b][m][n] = (f32x4){0.f, 0.f, 0.f, 0.f};
        }
        cur = nxt; cA = nA; cB = nB; ++ui;
        if constexpr (GATHER) {
#pragma unroll
            for (int h_ = 0; h_ < 2; ++h_)
#pragma unroll
                for (int i_ = 0; i_ < 2; ++i_) gc[h_][i_] = gn[h_][i_]; }
        if (wr == 1) PG8_BAR;
    }
    PG8_WAIT_V(0);
    PG8_BAR;
#undef PG8_AOFFS
#undef PG8_STAGE_A
#undef PG8_SA
#undef PG8_SB
#undef PG8_STAGE
#undef PG8_LDA
#undef PG8_LDB
#undef PG8_MMA
#undef PG8_WAIT_V
#undef PG8_WAIT_L
#undef PG8_BAR
#undef PG8_SCHED
}

#define EPI_LOOP_AIM _Pragma("unroll") for (int ai = 0; ai < 2; ++ai) _Pragma("unroll") for (int m = 0; m < 4; ++m)
struct EpiProj {
    static constexpr bool PERM = true;
    bf16_t* O; float* ssq_q; float* ssq_kv;
    DI void operator()(const f32x4 (&acc)[2][2][4][2], const Unit& u, int wr, int wc, int fr, int fq) const {
        const int row0 = u.pm * BM + wr * 64 + fr, col0 = u.pn * BM + wc * 32 + 8 * fq;
        const bool sq = (u.pn == 24 || u.pn == 25), skv = (u.pn == 26);
        EPI_LOOP_AIM { const int row = row0 + ai * HALF + m * 16; bf16_t* rowp = O + (size_t)row * NP + col0; float ss = 0.f;
#pragma unroll
            for (int bj = 0; bj < 2; ++bj) { const f32x4 v0 = acc[ai][bj][m][0], v1 = acc[ai][bj][m][1];
                u32x4 w; w.x = pk2(v0[0], v0[1]); w.y = pk2(v0[2], v0[3]); w.z = pk2(v1[0], v1[1]); w.w = pk2(v1[2], v1[3]);
                *(u32x4*)(rowp + bj * HALF) = w;
                ss += (v0[0] * v0[0] + v0[1] * v0[1]) + (v0[2] * v0[2] + v0[3] * v0[3]) + (v1[0] * v1[0] + v1[1] * v1[1]) + (v1[2] * v1[2] + v1[3] * v1[3]); }
            if (sq || skv) { ss += __shfl_xor(ss, 16); ss += __shfl_xor(ss, 32);
                if (fq == 0) { if (sq) ssq_q[(size_t)row * 8 + (u.pn - 24) * 4 + wc] = ss; else ssq_kv[(size_t)row * 4 + wc] = ss; } }
        }
    }
};
struct EpiQ {
    static constexpr bool PERM = true;
    bf16_t* Q; const float* ssq_q; const f32x2* rope;
    DI void operator()(const f32x4 (&acc)[2][2][4][2], const Unit& u, int wr, int wc, int fr, int fq) const {
        const int row0 = u.pm * BM + wr * 64 + fr, col0 = u.pn * BM + wc * 32 + 8 * fq;
        EPI_LOOP_AIM { const int row = row0 + ai * HALF + m * 16; const int pos = row & (SEQ - 1);
            const f32x4 s0 = *(const f32x4*)(ssq_q + (size_t)row * 8), s1 = *(const f32x4*)(ssq_q + (size_t)row * 8 + 4);
            const float rs = rsqrtf(((s0[0] + s0[1]) + (s0[2] + s0[3]) + (s1[0] + s1[1]) + (s1[2] + s1[3])) * (1.f / 512.f) + EPS) * QSCALE;
#pragma unroll
            for (int bj = 0; bj < 2; ++bj) { const int c = col0 + bj * HALF; const int j = c % 192;
                f32x4 v0 = acc[ai][bj][m][0] * rs, v1 = acc[ai][bj][m][1] * rs;
                if (j >= 128) { const int i0 = (j - 128) >> 1; const f32x2* rp = rope + (size_t)pos * 32 + i0;
                    const f32x2 c0 = rp[0], c1 = rp[1], c2 = rp[2], c3 = rp[3];
                    f32x4 w0, w1;
                    w0[0] = v0[0] * c0.x - v0[1] * c0.y; w0[1] = v0[1] * c0.x + v0[0] * c0.y; w0[2] = v0[2] * c1.x - v0[3] * c1.y; w0[3] = v0[3] * c1.x + v0[2] * c1.y;
                    w1[0] = v1[0] * c2.x - v1[1] * c2.y; w1[1] = v1[1] * c2.x + v1[0] * c2.y; w1[2] = v1[2] * c3.x - v1[3] * c3.y; w1[3] = v1[3] * c3.x + v1[2] * c3.y;
                    v0 = w0; v1 = w1; }
                u32x4 w; w.x = pk2(v0[0], v0[1]); w.y = pk2(v0[2], v0[3]); w.z = pk2(v1[0], v1[1]); w.w = pk2(v1[2], v1[3]);
                *(u32x4*)(Q + (size_t)row * 1536 + c) = w; }
        }
    }
};
struct EpiKV {
    static constexpr bool PERM = true;
    bf16_t* Kb; bf16_t* Vb; const float* ssq_kv;
    DI void operator()(const f32x4 (&acc)[2][2][4][2], const Unit& u, int wr, int wc, int fr, int fq) const {
        const int row0 = u.pm * BM + wr * 64 + fr, cc = wc * 32 + 8 * fq, hd = u.pn;
        EPI_LOOP_AIM { const int row = row0 + ai * HALF + m * 16;
            const f32x4 s0 = *(const f32x4*)(ssq_kv + (size_t)row * 4);
            const float rs = rsqrtf(((s0[0] + s0[1]) + (s0[2] + s0[3])) * (1.f / 256.f) + EPS);
#pragma unroll
            for (int bj = 0; bj < 2; ++bj) { const f32x4 v0 = acc[ai][bj][m][0] * rs, v1 = acc[ai][bj][m][1] * rs;
                u32x4 w; w.x = pk2(v0[0], v0[1]); w.y = pk2(v0[2], v0[3]); w.z = pk2(v1[0], v1[1]); w.w = pk2(v1[2], v1[3]);
                const unsigned th = (unsigned)(((row >> 13) * 8 + hd) * 128 + ((row & (SEQ - 1)) >> 6)), rr = (unsigned)(row & 63);
                if (bj == 0) *(u32x4*)(Kb + (th * 12288u + (unsigned)(cc >> 3) * 512u + rr * 8u)) = w;
                else *(u32x4*)(Vb + (th * 8192u + (unsigned)(cc >> 4) * 1024u + rr * 16u + (unsigned)(cc & 15))) = w; }
        }
    }
};
struct EpiMerge {
    static constexpr bool PERM = true, CHAIN = true;
    bf16_t* MG; const bf16_t* proj;
    DI void operator()(f32x4 (&acc)[2][2][4][2], const Unit& u, int wr, int wc, int fr, int fq) const {
        const int row0 = u.pm * BM + wr * 64 + fr, col0 = u.pn * BM + wc * 32 + 8 * fq;
        if (u.aux == 0) {
            EPI_LOOP_AIM { const int row = row0 + ai * HALF + m * 16;
#pragma unroll
                for (int bj = 0; bj < 2; ++bj) { const unsigned po = (unsigned)row * (unsigned)NP + (unsigned)(col0 + bj * HALF);
                    const u32x4 ga = __builtin_nontemporal_load((const u32x4*)(proj + (po + C_GA))), gb = *(const u32x4*)(proj + (po + C_GB));
                    const unsigned gaw[4] = {ga.x, ga.y, ga.z, ga.w}, gbw[4] = {gb.x, gb.y, gb.z, gb.w};
#pragma unroll
                    for (int q = 0; q < 4; ++q) { const float r0 = (1.f + __expf(-bflo(gbw[q]))) * __builtin_amdgcn_rcpf(1.f + __expf(-bflo(gaw[q]))), r1 = (1.f + __expf(-bfhi(gbw[q]))) * __builtin_amdgcn_rcpf(1.f + __expf(-bfhi(gaw[q])));
                        acc[ai][bj][m][q >> 1][(q & 1) * 2] *= r0; acc[ai][bj][m][q >> 1][(q & 1) * 2 + 1] *= r1; } }
            }
        } else {
            EPI_LOOP_AIM { const int row = row0 + ai * HALF + m * 16;
#pragma unroll
                for (int bj = 0; bj < 2; ++bj) { const int c = col0 + bj * HALF;
                    const u32x4 g = *(const u32x4*)(proj + ((unsigned)row * (unsigned)NP + (unsigned)(C_GB + c)));
                    const f32x4 v0 = acc[ai][bj][m][0], v1 = acc[ai][bj][m][1];
                    u32x4 w; w.x = pk2(sigmoidf_(bflo(g.x)) * v0[0], sigmoidf_(bfhi(g.x)) * v0[1]); w.y = pk2(sigmoidf_(bflo(g.y)) * v0[2], sigmoidf_(bfhi(g.y)) * v0[3]);
                    w.z = pk2(sigmoidf_(bflo(g.z)) * v1[0], sigmoidf_(bfhi(g.z)) * v1[1]); w.w = pk2(sigmoidf_(bflo(g.w)) * v1[2], sigmoidf_(bfhi(g.w)) * v1[3]);
                    *(u32x4*)(MG + (size_t)row * DM + c) = w; }
            }
        }
    }
};
struct EpiRes {
    static constexpr bool PERM = false;
    const float* X; float* X1;
    DI void operator()(const f32x4 (&acc)[2][2][4][2], const Unit& u, int wr, int wc, int fr, int fq) const {
        const int row0 = u.pm * BM + wr * 64 + fr, col0 = u.pn * BM + wc * 32 + 4 * fq;
        EPI_LOOP_AIM { const size_t off = (size_t)(row0 + ai * HALF + m * 16) * DM + col0;
#pragma unroll
            for (int bj = 0; bj < 2; ++bj)
#pragma unroll
                for (int n = 0; n < 2; ++n) { const f32x4 b = __builtin_nontemporal_load((const f32x4*)(X + off + bj * HALF + n * 16)); *(f32x4*)(X1 + off + bj * HALF + n * 16) = b + acc[ai][bj][m][n]; }
        }
    }
};
struct EpiGU {
    static constexpr bool PERM = true;
    bf16_t* ACT; const float* bias;
    DI void operator()(const f32x4 (&acc)[2][2][4][2], const Unit& u, int wr, int wc, int fr, int fq) const {
        const int row0 = u.pm * BM + wr * 64 + fr, col0 = u.pn * BM + wc * 32 + 8 * fq;
        const float* bp = bias + (size_t)u.aux * 2048 + col0;
        f32x4 bv[2][2];
#pragma unroll
        for (int bj = 0; bj < 2; ++bj) { bv[bj][0] = *(const f32x4*)(bp + bj * HALF); bv[bj][1] = *(const f32x4*)(bp + bj * HALF + 4); }
        EPI_LOOP_AIM { const int row = row0 + ai * HALF + m * 16;
#pragma unroll
            for (int bj = 0; bj < 2; ++bj) { const f32x4 v0 = acc[ai][bj][m][0] * F8_UNSCALE + bv[bj][0], v1 = acc[ai][bj][m][1] * F8_UNSCALE + bv[bj][1];
                float a[4]; constexpr float SCF = (float)(1 << F8_CSHIFT);
                { const float g = fminf(v0[0], 7.f), up = __builtin_amdgcn_fmed3f(v0[1], -7.f, 7.f); a[0] = (up * SCF + SCF) * (g * __builtin_amdgcn_rcpf(1.f + __builtin_amdgcn_exp2f(g * (-1.702f * 1.4426950408889634f)))); }
                { const float g = fminf(v0[2], 7.f), up = __builtin_amdgcn_fmed3f(v0[3], -7.f, 7.f); a[1] = (up * SCF + SCF) * (g * __builtin_amdgcn_rcpf(1.f + __builtin_amdgcn_exp2f(g * (-1.702f * 1.4426950408889634f)))); }
                { const float g = fminf(v1[0], 7.f), up = __builtin_amdgcn_fmed3f(v1[1], -7.f, 7.f); a[2] = (up * SCF + SCF) * (g * __builtin_amdgcn_rcpf(1.f + __builtin_amdgcn_exp2f(g * (-1.702f * 1.4426950408889634f)))); }
                { const float g = fminf(v1[2], 7.f), up = __builtin_amdgcn_fmed3f(v1[3], -7.f, 7.f); a[3] = (up * SCF + SCF) * (g * __builtin_amdgcn_rcpf(1.f + __builtin_amdgcn_exp2f(g * (-1.702f * 1.4426950408889634f)))); }
                int pk = __builtin_amdgcn_cvt_pk_fp8_f32(a[0], a[1], 0, false); pk = __builtin_amdgcn_cvt_pk_fp8_f32(a[2], a[3], pk, true);
                *(int*)((unsigned char*)ACT + (size_t)row * 1024 + ((col0 + bj * HALF) >> 1)) = pk; }
        }
    }
};
struct EpiDown {
    static constexpr bool PERM = true;
    bf16_t* YS; const float* bias;
    DI void operator()(const f32x4 (&acc)[2][2][4][2], const Unit& u, int wr, int wc, int fr, int fq) const {
        const int row0 = u.pm * BM + wr * 64 + fr, col0 = u.pn * BM + wc * 32 + 8 * fq;
        const float* bp = bias + (size_t)u.aux * 1024 + col0;
        f32x4 bv[2][2];
#pragma unroll
        for (int bj = 0; bj < 2; ++bj) { bv[bj][0] = *(const f32x4*)(bp + bj * HALF); bv[bj][1] = *(const f32x4*)(bp + bj * HALF + 4); }
        EPI_LOOP_AIM { const int row = row0 + ai * HALF + m * 16;
#pragma unroll
            for (int bj = 0; bj < 2; ++bj) { const f32x4 v0 = acc[ai][bj][m][0] * F8_UNSCALE_DOWN + bv[bj][0], v1 = acc[ai][bj][m][1] * F8_UNSCALE_DOWN + bv[bj][1];
                constexpr float sc = (float)(1 << F8_YSHIFT);
                int p0 = __builtin_amdgcn_cvt_pk_fp8_f32(__builtin_amdgcn_fmed3f(v0[0] * sc, -448.f, 448.f), __builtin_amdgcn_fmed3f(v0[1] * sc, -448.f, 448.f), 0, false);
                p0 = __builtin_amdgcn_cvt_pk_fp8_f32(__builtin_amdgcn_fmed3f(v0[2] * sc, -448.f, 448.f), __builtin_amdgcn_fmed3f(v0[3] * sc, -448.f, 448.f), p0, true);
                int p1 = __builtin_amdgcn_cvt_pk_fp8_f32(__builtin_amdgcn_fmed3f(v1[0] * sc, -448.f, 448.f), __builtin_amdgcn_fmed3f(v1[1] * sc, -448.f, 448.f), 0, false);
                p1 = __builtin_amdgcn_cvt_pk_fp8_f32(__builtin_amdgcn_fmed3f(v1[2] * sc, -448.f, 448.f), __builtin_amdgcn_fmed3f(v1[3] * sc, -448.f, 448.f), p1, true);
                u32x2 w; w.x = (unsigned)p0; w.y = (unsigned)p1;
                *(u32x2*)((unsigned char*)YS + (size_t)row * 1024 + col0 + bj * HALF) = w; }
        }
    }
};
struct EpiQKV {
    static constexpr bool PERM = true;
    EpiQ q; EpiKV kv;
    DI void operator()(const f32x4 (&acc)[2][2][4][2], const Unit& u, int wr, int wc, int fr, int fq) const { if (u.aux) kv(acc, u, wr, wc, fr, fq); else q(acc, u, wr, wc, fr, fq); }
};
}

struct Args { const float* in[22]; float* out; unsigned char* ws; int ph_lo, ph_hi; };
enum { I_X = 0, I_NMIX, I_WIN, I_CONVW, I_ALOG, I_DTB, I_GNW, I_WGDNO, I_QNW, I_WQB, I_KVNW, I_WKVB, I_WMLAO, I_WOUT, I_NFFN, I_WR, I_BR, I_WGU, I_BGU, I_WD, I_BD, I_NFIN };

__constant__ double ROPE_REV[32] = {
    0.15915494309189535, 0.11934937021124886, 0.08949940160889101, 0.06711508300522726, 0.050329212104487035, 0.03774158471741977, 0.0283021958306234, 0.02122365276477766,
    0.015915494309189534, 0.011934937021124886, 0.008949940160889102, 0.006711508300522725, 0.005032921210448704, 0.003774158471741977, 0.00283021958306234, 0.0021223652764777662,
    0.0015915494309189536, 0.0011934937021124885, 0.0008949940160889102, 0.0006711508300522726, 0.0005032921210448703, 0.00037741584717419774, 0.00028302195830623395, 0.0002122365276477766,
    0.00015915494309189535, 0.00011934937021124886, 8.949940160889102e-05, 6.711508300522725e-05, 5.0329212104487035e-05, 3.774158471741978e-05, 2.8302195830623396e-05, 2.122365276477766e-05};

struct MapId { DI int operator()(int n) const { return n; } };
struct MapWin { DI int operator()(int n) const {
    if (n < 4096) return n;
    if (n < 5120) return 4944 + (n - 4096);
    if (n < 6144) return 5968 + (n - 5120);
    if (n < 6656) return 4112 + (n - 6144);
    if (n < 6912) return 4624 + (n - 6656);
    if (n < 6976) { const int j = n - 6912; return 4880 + (j >> 1) + 32 * (j & 1); }
    if (n < 6984) return 4096 + (n - 6976);
    if (n < 6992) return 4104 + (n - 6984);
    return -1; } };
struct MapQb { DI int operator()(int n) const { const int hd = n / 192, j = n % 192; if (j < 128) return n; const int jj = j - 128; return hd * 192 + 128 + (jj >> 1) + 32 * (jj & 1); } };

template <class Map, bool NT_STORE = false>
DI void tr_item(const float* __restrict__ W, int ldw, bf16_t* WT, int K, int nblk, int item, const float* kscale, LAS float* scr, int lane, Map map) {
    const int kb = item / nblk, nb = item % nblk, k0 = 64 * kb, n0 = 64 * nb;
    const int kq = lane >> 4, n4 = 4 * (lane & 15);
    const int sc = map(n0 + n4);
    const bool contig = (sc >= 0) && (map(n0 + n4 + 1) == sc + 1) && (map(n0 + n4 + 2) == sc + 2) && (map(n0 + n4 + 3) == sc + 3);
    f32x4 v[16];
    if (contig) {
#pragma unroll
        for (int i = 0; i < 16; ++i) v[i] = __builtin_nontemporal_load((const f32x4*)(W + (size_t)(k0 + 4 * i + kq) * ldw + sc));
    } else {
        const int s0 = map(n0 + n4), s1 = map(n0 + n4 + 1), s2 = map(n0 + n4 + 2), s3 = map(n0 + n4 + 3);
#pragma unroll
        for (int i = 0; i < 16; ++i) { const float* wr = W + (size_t)(k0 + 4 * i + kq) * ldw;
            v[i][0] = s0 >= 0 ? wr[s0] : 0.f; v[i][1] = s1 >= 0 ? wr[s1] : 0.f; v[i][2] = s2 >= 0 ? wr[s2] : 0.f; v[i][3] = s3 >= 0 ? wr[s3] : 0.f; }
    }
#pragma unroll
    for (int i = 0; i < 16; ++i) { const int kk = 4 * i + kq; f32x4 x = v[i]; if (kscale) x = x * kscale[k0 + kk];
        scr[kk * 65 + n4] = x[0]; scr[kk * 65 + n4 + 1] = x[1]; scr[kk * 65 + n4 + 2] = x[2]; scr[kk * 65 + n4 + 3] = x[3]; }
    LDS_WAIT();
    const int c = lane & 7;
#pragma unroll
    for (int j = 0; j < 8; ++j) { const int n = (lane >> 3) + 8 * j; const LAS float* s = scr + (8 * c) * 65 + n;
        u32x4 o; o.x = pk2(s[0], s[65]); o.y = pk2(s[2 * 65], s[3 * 65]); o.z = pk2(s[4 * 65], s[5 * 65]); o.w = pk2(s[6 * 65], s[7 * 65]);
        if (NT_STORE) __builtin_nontemporal_store(o, (u32x4*)(WT + (size_t)(n0 + n) * K + k0 + 8 * c)); else *(u32x4*)(WT + (size_t)(n0 + n) * K + k0 + 8 * c) = o; }
    LDS_WAIT();
}

DI void phase_prologue(const Args& a, LAS unsigned char* lds) {
    const int tid = tidx(), lane = tid & 63, wave = tid >> 6;
    const int gw = blockIdx.x * 8 + wave, NGW = gridDim.x * 8;
    LAS float* scr = (LAS float*)(lds + wave * 16640);
    unsigned char* ws = a.ws;
    constexpr int N0 = 1792, N1 = 256, N4 = 192, N5 = 128;
    constexpr int NITEMS = N0 + 3 * N1 + N4 + N5;
    for (int it = gw; it < NITEMS; it += NGW) {
        int r = it;
        if (r < N1) { tr_item(a.in[I_WGDNO], 1024, (bf16_t*)(ws + WS_WGDNO), 1024, 16, r, nullptr, scr, lane, MapId()); continue; } r -= N1;
        if (r < N1) { tr_item(a.in[I_WMLAO], 1024, (bf16_t*)(ws + WS_WMLAO), 1024, 16, r, nullptr, scr, lane, MapId()); continue; } r -= N1;
        if (r < N1) { tr_item(a.in[I_WOUT], 1024, (bf16_t*)(ws + WS_WOUT), 1024, 16, r, nullptr, scr, lane, MapId()); continue; } r -= N1;
        if (r < N4) { tr_item(a.in[I_WQB], 1536, (bf16_t*)(ws + WS_WQB), 512, 24, r, a.in[I_QNW], scr, lane, MapQb()); continue; } r -= N4;
        if (r < N5) { tr_item(a.in[I_WKVB], 2048, (bf16_t*)(ws + WS_WKVB), 512, 32, r, a.in[I_KVNW], scr, lane, MapId());     continue; } r -= N5;
        tr_item(a.in[I_WIN], 6992, (bf16_t*)(ws + WS_WIN), 1024, 112, r, nullptr, scr, lane, MapWin());
    }
    {
        const float* nw = a.in[I_NMIX]; bf16_t* XN = (bf16_t*)(ws + WS_XN);
        f32x4 wv[4];
#pragma unroll
        for (int j = 0; j < 4; ++j) wv[j] = *(const f32x4*)(nw + 256 * j + 4 * lane);
#pragma unroll 2
        for (int m = gw; m < T_TOK; m += NGW) {
            const float* xr = a.in[I_X] + (size_t)m * DM + 4 * lane; f32x4 v[4]; float s = 0.f;
#pragma unroll
            for (int j = 0; j < 4; ++j) { v[j] = __builtin_nontemporal_load((const f32x4*)(xr + 256 * j)); s += (v[j][0] * v[j][0] + v[j][1] * v[j][1]) + (v[j][2] * v[j][2] + v[j][3] * v[j][3]); }
            const float rs = rsqrtf(wave_sum(s) * (1.f / DM) + EPS);
            bf16_t* o = XN + (size_t)m * DM + 4 * lane;
#pragma unroll
            for (int j = 0; j < 4; ++j) { u32x2 w; w.x = pk2(v[j][0] * rs * wv[j][0], v[j][1] * rs * wv[j][1]); w.y = pk2(v[j][2] * rs * wv[j][2], v[j][3] * rs * wv[j][3]); *(u32x2*)(o + 256 * j) = w; }
        }
    }
    {
        f32x2* rt = (f32x2*)(ws + WS_ROPE);
        for (int idx = blockIdx.x * 512 + tid; idx < SEQ * 32; idx += gridDim.x * 512) {
            const int pos = idx >> 5, i = idx & 31; const double rev = (double)pos * ROPE_REV[i]; const float fr = (float)(rev - floor(rev));
            f32x2 cs; cs.x = __builtin_amdgcn_cosf(fr); cs.y = __builtin_amdgcn_sinf(fr); rt[idx] = cs;
        }
    }
}

constexpr int PL_TI = 149504;
constexpr int XLD = 260;
constexpr int PL_KN = 0, PL_QN = 17408, PL_VB = 34816, PL_LD = 52224, PL_LB = 57344, PL_SM = 66560, PL_QKM = 67584, PL_X = 76800, PL_CW = 143360;
DI void gdn_prep_load(const Args& a, int bh, int ch, int tid, u32x4 (&xr)[3][5]) {
    const int b = bh >> 3, h = bh & 7, cgi = tid & 15, tg = tid >> 4; const int s0 = ch * 64 + 2 * tg - 3;
    const bf16_t* proj = (const bf16_t*)(a.ws + WS_PROJ); const size_t rowb = (size_t)b * SEQ;
#pragma unroll
    for (int p = 0; p < 3; ++p) { const int col = p * 1024 + h * 128 + 8 * cgi;
#pragma unroll
        for (int r = 0; r < 5; ++r) { const int s = s0 + r; xr[p][r] = (s >= 0) ? *(const u32x4*)(proj + (rowb + s) * NP + col) : (u32x4){0u, 0u, 0u, 0u}; } }
}
DI void gdn_prep_unit(const Args& a, LAS unsigned char* lds, int bh, int ch, u32x4 (&xr)[3][5], int bh_n, int ch_n, bool load_w) {
    const int tid = tidx(), lane = tid & 63, wid = __builtin_amdgcn_readfirstlane(tid >> 6);
    const int b = bh >> 3, h = bh & 7;
    LAS bf16_t* KN = (LAS bf16_t*)(lds + PL_KN); LAS bf16_t* QN = (LAS bf16_t*)(lds + PL_QN); LAS bf16_t* VB = (LAS bf16_t*)(lds + PL_VB);
    LAS float* LD = (LAS float*)(lds + PL_LD); LAS bf16_t* LB = (LAS bf16_t*)(lds + PL_LB); LAS float* XS_ = (LAS float*)(lds + PL_X); LAS float* SM = (LAS float*)(lds + PL_SM); LAS bf16_t* QKM = (LAS bf16_t*)(lds + PL_QKM);
    LAS float* BETA = SM; LAS float* DG = SM + 64; LAS float* GC = SM + 128; LAS float* EG = SM + 192;
    const bf16_t* proj = (const bf16_t*)(a.ws + WS_PROJ);
    const size_t rowb = (size_t)b * SEQ;
    LAS float* CW = (LAS float*)(lds + PL_CW);
    if (load_w) {
        if (tid < 384) {
#pragma unroll
            for (int j = 0; j < 4; ++j) CW[j * 384 + tid] = a.in[I_CONVW][j * 3072 + (tid >> 7) * 1024 + h * 128 + (tid & 127)]; }
        __syncthreads();
    }
    {
        const int cgi = tid & 15, tg = tid >> 4;
        const float beta0 = sigmoidf_(bf2f(proj[(rowb + ch * 64 + 2 * tg) * NP + C_BG + h])), beta1 = sigmoidf_(bf2f(proj[(rowb + ch * 64 + 2 * tg + 1) * NP + C_BG + h]));
        if (wid == 0) {
            const float A = __expf(a.in[I_ALOG][h]), dtb = a.in[I_DTB][h];
            const float xg = bf2f(proj[(rowb + ch * 64 + lane) * NP + C_AG + h]) + dtb, bt = sigmoidf_(bf2f(proj[(rowb + ch * 64 + lane) * NP + C_BG + h]));
            float x = -A * (fmaxf(xg, 0.f) + log1pf(__expf(-fabsf(xg))));
#pragma unroll
            for (int d = 1; d < 64; d <<= 1) { const float v = __shfl_up(x, d); if (lane >= d) x += v; }
            BETA[lane] = bt; GC[lane] = x; EG[lane] = __expf(x); DG[lane] = __expf(__shfl(x, 63) - x);
            if (lane == 63) ((float*)(a.ws + WS_GLAST))[bh * 128 + ch] = __expf(x);
        }
#pragma unroll
        for (int p = 0; p < 3; ++p) {
            const int col = p * 1024 + h * 128 + 8 * cgi;
            float y0[8], y1[8];
#pragma unroll
            for (int e = 0; e < 8; ++e) { y0[e] = 0.f; y1[e] = 0.f; }
#pragma unroll
            for (int j = 0; j < 4; ++j) {
                const f32x4 wa = *(const LAS f32x4*)(CW + j * 384 + p * 128 + 8 * cgi), wb = *(const LAS f32x4*)(CW + j * 384 + p * 128 + 8 * cgi + 4);
                const float w8[8] = {wa[0], wa[1], wa[2], wa[3], wb[0], wb[1], wb[2], wb[3]};
                const u32x4 r0 = xr[p][j], r1 = xr[p][j + 1];
                const float x0[8] = {bflo(r0.x), bfhi(r0.x), bflo(r0.y), bfhi(r0.y), bflo(r0.z), bfhi(r0.z), bflo(r0.w), bfhi(r0.w)};
                const float x1[8] = {bflo(r1.x), bfhi(r1.x), bflo(r1.y), bfhi(r1.y), bflo(r1.z), bfhi(r1.z), bflo(r1.w), bfhi(r1.w)};
#pragma unroll
                for (int e = 0; e < 8; ++e) { y0[e] += w8[e] * x0[e]; y1[e] += w8[e] * x1[e]; }
            }
            float ss0 = 0.f, ss1 = 0.f;
#pragma unroll
            for (int e = 0; e < 8; ++e) { y0[e] = y0[e] * sigmoidf_(y0[e]); y1[e] = y1[e] * sigmoidf_(y1[e]); ss0 += y0[e] * y0[e]; ss1 += y1[e] * y1[e]; }
            float f0, f1;
            if (p < 2) {
#pragma unroll
                for (int o = 1; o < 16; o <<= 1) { ss0 += __shfl_xor(ss0, o); ss1 += __shfl_xor(ss1, o); }
                const float sc = (p == 0) ? 0.08838834764831845f : 1.f;
                f0 = rsqrtf(ss0 + EPS) * sc; f1 = rsqrtf(ss1 + EPS) * sc;
            } else { f0 = beta0; f1 = beta1; }
            LAS bf16_t* img = (p == 0) ? QN : (p == 1) ? KN : VB;
            u32x4 w0, w1;
            w0.x = pk2(y0[0] * f0, y0[1] * f0); w0.y = pk2(y0[2] * f0, y0[3] * f0); w0.z = pk2(y0[4] * f0, y0[5] * f0); w0.w = pk2(y0[6] * f0, y0[7] * f0);
            w1.x = pk2(y1[0] * f1, y1[1] * f1); w1.y = pk2(y1[2] * f1, y1[3] * f1); w1.z = pk2(y1[4] * f1, y1[5] * f1); w1.w = pk2(y1[6] * f1, y1[7] * f1);
            *(LAS u32x4*)(img + (2 * tg) * 136 + 8 * cgi) = w0; *(LAS u32x4*)(img + (2 * tg + 1) * 136 + 8 * cgi) = w1;
        }
    }
    if (bh_n >= 0) gdn_prep_load(a, bh_n, ch_n, tid, xr);
    RAW_BAR();
    {
        const int mat = wid >> 2, ti = (wid >> 1) & 1, tj = wid & 1, r = lane & 31, hh = lane >> 5;
        LAS bf16_t* Aimg = mat ? QN : KN;
        f32x16 acc;
#pragma unroll
        for (int i = 0; i < 16; ++i) acc[i] = 0.f;
#pragma unroll
        for (int s = 0; s < 8; ++s) { const bf16x8 av = *(const LAS bf16x8*)(Aimg + (32 * ti + r) * 136 + 16 * s + 8 * hh), bv = *(const LAS bf16x8*)(KN + (32 * tj + r) * 136 + 16 * s + 8 * hh); acc = MFMA32(av, bv, acc); }
        const int mcol = 32 * tj + r; const float gm = GC[mcol];
        f32x4 gc4[4], be4[4];
#pragma unroll
        for (int g4 = 0; g4 < 4; ++g4) { gc4[g4] = *(const LAS f32x4*)(GC + 32 * ti + 8 * g4 + 4 * hh); be4[g4] = *(const LAS f32x4*)(BETA + 32 * ti + 8 * g4 + 4 * hh); }
#pragma unroll
        for (int i = 0; i < 16; ++i) { const int c = 32 * ti + crow(i, hh); const float dec = __expf(gc4[i >> 2][i & 3] - gm);
            if (mat == 0) { const float lv = (c > mcol) ? acc[i] * be4[i >> 2][i & 3] * dec : 0.f; LB[c * 72 + mcol] = f2bf(-lv); if ((c >> 4) == (mcol >> 4)) LD[(c >> 4) * 320 + (c & 15) * 20 + (mcol & 15)] = lv; }
            else QKM[c * 72 + mcol] = f2bf((c >= mcol) ? acc[i] * dec : 0.f); }
    }
    RAW_BAR();
    unsigned char* fr = a.ws + WS_FR + (size_t)(bh * 128 + ch) * FR_UNIT;
    LAS float* TI = (LAS float*)(lds + PL_TI);
    if (wid >= 4) {
        const int t4 = tid - 256;
        const float gl = GC[63];
#pragma unroll
        for (int it = 0; it < 4; ++it) { const int item = t4 + 256 * it, ln = item & 63, ks = (item >> 6) & 7, tile = item >> 9; const int row = 32 * tile + (ln & 31), hh = ln >> 5, d0 = 16 * ks + 4 * hh;
            const float eg = EG[row]; const u32x2 lo = *(const LAS u32x2*)(QN + row * 136 + d0), hi = *(const LAS u32x2*)(QN + row * 136 + d0 + 8);
            u32x4 w; w.x = pk2(bflo(lo.x) * eg, bfhi(lo.x) * eg); w.y = pk2(bflo(lo.y) * eg, bfhi(lo.y) * eg); w.z = pk2(bflo(hi.x) * eg, bfhi(hi.x) * eg); w.w = pk2(bflo(hi.y) * eg, bfhi(hi.y) * eg);
            *(u32x4*)(fr + FR_QD + (size_t)item * 16) = w; }
#pragma unroll
        for (int it = 0; it < 4; ++it) { const int item = t4 + 256 * it, ln = item & 63, ks = (item >> 6) & 3, Tt = item >> 8; const int dk = 32 * Tt + (ln & 31), hh = ln >> 5, t0 = 16 * ks + 4 * hh;
            float v[8];
#pragma unroll
            for (int q2 = 0; q2 < 2; ++q2) { const int l16 = ln & 15;
                const s16x4 t = __builtin_bit_cast(s16x4, __builtin_amdgcn_ds_read_tr16_b64_v4i16((LAS s16x4*)(KN + (t0 + 8 * q2 + (l16 >> 2)) * 136 + (dk & ~15) + 4 * (l16 & 3))));
                const f32x4 dg = *(const LAS f32x4*)(DG + t0 + 8 * q2);
#pragma unroll
                for (int jq = 0; jq < 4; ++jq) v[4 * q2 + jq] = bf2f((bf16_t)t[jq]) * dg[jq]; }
            u32x4 w; w.x = pk2(v[0], v[1]); w.y = pk2(v[2], v[3]); w.z = pk2(v[4], v[5]); w.w = pk2(v[6], v[7]);
            *(u32x4*)(fr + FR_KD + (size_t)item * 16) = w; }
#pragma unroll
        for (int it = 0; it < 2; ++it) { const int item = t4 + 256 * it, ln = item & 63, ks = (item >> 6) & 3, tile = item >> 8; const int row = 32 * tile + (ln & 31), hh = ln >> 5, m0 = 16 * ks + 4 * hh;
            const u32x2 lo = *(const LAS u32x2*)(QKM + row * 72 + m0), hi = *(const LAS u32x2*)(QKM + row * 72 + m0 + 8);
            u32x4 w; w.x = lo.x; w.y = lo.y; w.z = hi.x; w.w = hi.y;
            *(u32x4*)(fr + FR_QK + (size_t)item * 16) = w; }
    } else {
        const int j = lane & 15;
        float x[16];
#pragma unroll
        for (int i = 0; i < 16; ++i) x[i] = (i == j) ? 1.f : 0.f;
#pragma unroll
        for (int i = 1; i < 16; ++i) {
#pragma unroll
            for (int q = 0; q < 4; ++q) if (4 * q < i) { const f32x4 l = *(const LAS f32x4*)(LD + wid * 320 + i * 20 + 4 * q);
                x[i] -= l[0] * x[4 * q]; if (4 * q + 1 < i) x[i] -= l[1] * x[4 * q + 1]; if (4 * q + 2 < i) x[i] -= l[2] * x[4 * q + 2]; if (4 * q + 3 < i) x[i] -= l[3] * x[4 * q + 3]; }
        }
        if (lane < 16) {
#pragma unroll
            for (int i = 0; i < 16; ++i) TI[wid * 320 + i * 20 + j] = x[i]; }
    }
    RAW_BAR();
    {
        const int n16 = lane & 15, kk = lane >> 4;
        f32x4 R[4][2];
        { LAS const bf16_t* img = (wid < 4) ? VB : KN; const int cbase = (wid < 4) ? 32 * wid : 32 * wid - 128;
#pragma unroll
          for (int rb = 0; rb < 4; ++rb) {
              f32x4 sc = {1.f, 1.f, 1.f, 1.f};
              if (wid >= 4) { const f32x4 be = *(const LAS f32x4*)(BETA + 16 * rb + 4 * kk), eg = *(const LAS f32x4*)(EG + 16 * rb + 4 * kk); sc = be * eg; }
#pragma unroll
              for (int cb = 0; cb < 2; ++cb) {
                  const s16x4 t = __builtin_bit_cast(s16x4, __builtin_amdgcn_ds_read_tr16_b64_v4i16((LAS s16x4*)(img + (16 * rb + 4 * kk + (n16 >> 2)) * 136 + cbase + 16 * cb + 4 * (n16 & 3))));
#pragma unroll
                  for (int i = 0; i < 4; ++i) R[rb][cb][i] = bf2f((bf16_t)t[i]) * sc[i]; } } }
#pragma unroll
        for (int b = 0; b < 4; ++b) {
            const f32x4 tiv = *(const LAS f32x4*)(TI + b * 320 + n16 * 20 + 4 * kk);
            f32x4 X[2];
#pragma unroll
            for (int cb = 0; cb < 2; ++cb) { X[cb] = (f32x4){0.f, 0.f, 0.f, 0.f};
#pragma unroll
                for (int s4 = 0; s4 < 4; ++s4) X[cb] = __builtin_amdgcn_mfma_f32_16x16x4f32(tiv[s4], R[b][cb][s4], X[cb], 0, 0, 0); }
#pragma unroll
            for (int cb = 0; cb < 2; ++cb)
#pragma unroll
                for (int i = 0; i < 4; ++i) XS_[(16 * b + 4 * kk + i) * XLD + 32 * wid + 16 * cb + n16] = X[cb][i];
            s16x4 xb[2];
#pragma unroll
            for (int cb = 0; cb < 2; ++cb) { u32x2 pk; pk.x = pk2(X[cb][0], X[cb][1]); pk.y = pk2(X[cb][2], X[cb][3]); xb[cb] = __builtin_bit_cast(s16x4, pk); }
#pragma unroll
            for (int rb = b + 1; rb < 4; ++rb) {
                const s16x4 lw = *(const LAS s16x4*)(LB + (16 * rb + n16) * 72 + 16 * b + 4 * kk);
#pragma unroll
                for (int cb = 0; cb < 2; ++cb) R[rb][cb] = __builtin_amdgcn_mfma_f32_16x16x16bf16_1k(lw, xb[cb], R[rb][cb], 0, 0, 0);
            }
        }
    }
    RAW_BAR();
    {
#pragma unroll
        for (int it = 0; it < 2; ++it) { const int item = tid + 512 * it, ln = item & 63, ks = (item >> 6) & 7, tile = item >> 9; const int row = 32 * tile + (ln & 31), hh = ln >> 5, d0 = 128 + 16 * ks + 4 * hh;
            const f32x4 lo = *(const LAS f32x4*)(XS_ + row * XLD + d0), hi = *(const LAS f32x4*)(XS_ + row * XLD + d0 + 8);
            u32x4 w; w.x = pk2(-lo[0], -lo[1]); w.y = pk2(-lo[2], -lo[3]); w.z = pk2(-hi[0], -hi[1]); w.w = pk2(-hi[2], -hi[3]);
            *(u32x4*)(fr + FR_NW + (size_t)item * 16) = w; }
        { const int item = tid, ln = item & 63, tile = (item >> 6) & 1, sl = item >> 7; const int col = 32 * sl + (ln & 31), hh = ln >> 5;
            unsigned w[8];
#pragma unroll
            for (int rr = 0; rr < 8; ++rr) { const int t0 = 32 * tile + crow(2 * rr, hh), t1 = 32 * tile + crow(2 * rr + 1, hh); w[rr] = pk2(XS_[t0 * XLD + col], XS_[t1 * XLD + col]); }
            u32x4 wa = {w[0], w[1], w[2], w[3]}, wb = {w[4], w[5], w[6], w[7]};
            *(u32x4*)(fr + FR_U + (size_t)item * 32) = wa; *(u32x4*)(fr + FR_U + (size_t)item * 32 + 16) = wb; }
    }
}

DI void krope_pass(const Args& a) {
    const bf16_t* proj = (const bf16_t*)(a.ws + WS_PROJ); bf16_t* Kb = (bf16_t*)(a.ws + WS_K); const f32x2* rope = (const f32x2*)(a.ws + WS_ROPE);
    for (int idx = blockIdx.x * 512 + tidx(); idx < T_TOK * 8; idx += gridDim.x * 512) {
        const int row = idx >> 3, g = idx & 7, pos = row & (SEQ - 1);
        const u32x4 v = *(const u32x4*)(proj + (size_t)row * NP + C_KR + 8 * g);
        const f32x2* rp = rope + (size_t)pos * 32 + 4 * g;
        const unsigned vv[4] = {v.x, v.y, v.z, v.w}; unsigned o[4];
#pragma unroll
        for (int q = 0; q < 4; ++q) { const float x0 = bflo(vv[q]), x1 = bfhi(vv[q]); const f32x2 cs = rp[q]; o[q] = pk2(x0 * cs.x - x1 * cs.y, x1 * cs.x + x0 * cs.y); }
        const u32x4 w = {o[0], o[1], o[2], o[3]};
        const int bb = row >> 13, sq = row & (SEQ - 1), tl = sq >> 6, rr = sq & 63;
#pragma unroll
        for (int hd = 0; hd < 8; ++hd) *(u32x4*)(Kb + ((size_t)(bb * 8 + hd) * 128 + tl) * 12288 + (16 + g) * 512 + rr * 8) = w;
    }
}

constexpr int SC_GLS = 147456;
#define GLDS16(gsrc, ldst) __builtin_amdgcn_global_load_lds((const unsigned*)(gsrc), (LAS unsigned*)(ldst), 16, 0, 0)
#define GLDS16_NT(gsrc, ldst) __builtin_amdgcn_global_load_lds((const unsigned*)(gsrc), (LAS unsigned*)(ldst), 16, 0, 2)
#define WAIT_VM0() asm volatile("s_waitcnt vmcnt(0)" ::: "memory")
DI void scan_store_o(bf16_t* op, const unsigned (&opk)[16], int hh) {
#pragma unroll
    for (int tile = 0; tile < 2; ++tile)
#pragma unroll
        for (int rr = 0; rr < 8; ++rr) { const unsigned w = opk[tile * 8 + rr];
            op[(size_t)(32 * tile + crow(2 * rr, hh)) * DM] = (bf16_t)(w & 0xffffu); op[(size_t)(32 * tile + crow(2 * rr + 1, hh)) * DM] = (bf16_t)(w >> 16); }
}
DI void gdn_scan_wg(const Args& a, LAS unsigned char* lds, int bh) {
    const int tid = tidx(), lane = tid & 63, wid = __builtin_amdgcn_readfirstlane(tid >> 6);
    const int b = bh >> 3, h = bh & 7, n = lane & 31, hh = lane >> 5, sl = wid;
    const unsigned char* frb = a.ws + WS_FR + (size_t)bh * 128 * FR_UNIT;
    LAS float* gls = (LAS float*)(lds + SC_GLS);
    if (tid < 128) gls[tid] = ((const float*)(a.ws + WS_GLAST))[bh * 128 + tid];
#pragma unroll
    for (int i = 0; i < 9; ++i) { const int pc = wid + 8 * i; GLDS16_NT(frb + (size_t)pc * 1024 + lane * 16, lds + pc * 1024); }
    WAIT_VM0(); RAW_BAR();
    bf16_t* OA = (bf16_t*)(a.ws + WS_OA) + ((size_t)b * SEQ) * DM + h * 128 + 32 * sl + n;
    f32x16 S[4];
#pragma unroll
    for (int t = 0; t < 4; ++t)
#pragma unroll
        for (int i = 0; i < 16; ++i) S[t][i] = 0.f;
    unsigned opk[16];
#pragma unroll
    for (int i = 0; i < 16; ++i) opk[i] = 0u;
    for (int ch = 0; ch < 128; ++ch) {
        LAS const unsigned char* fb = lds + (ch & 1) * FR_UNIT;
        if (ch + 1 < 128) { const unsigned char* src = frb + (size_t)(ch + 1) * FR_UNIT; LAS unsigned char* dst = lds + ((ch + 1) & 1) * FR_UNIT;
#pragma unroll
            for (int i = 0; i < 9; ++i) { const int pc = wid + 8 * i; GLDS16_NT(src + (size_t)pc * 1024 + lane * 16, dst + pc * 1024); } }
        if (wid < 4) {
            if (ch > 0) scan_store_o(OA + (size_t)(ch - 1) * 64 * DM, opk, hh);
            const float gl = gls[ch];
            bf16x8 Sb[8];
#pragma unroll
            for (int t = 0; t < 4; ++t) { Sb[2 * t] = pack_step(S[t], 0); Sb[2 * t + 1] = pack_step(S[t], 1); }
            f32x16 vn[2], o[2];
#pragma unroll
            for (int tile = 0; tile < 2; ++tile) {
                const u32x4 ua = *(const LAS u32x4*)(fb + FR_U + ((sl * 2 + tile) * 64 + lane) * 32), ub = *(const LAS u32x4*)(fb + FR_U + ((sl * 2 + tile) * 64 + lane) * 32 + 16);
                const unsigned uw[8] = {ua.x, ua.y, ua.z, ua.w, ub.x, ub.y, ub.z, ub.w};
#pragma unroll
                for (int rr = 0; rr < 8; ++rr) { vn[tile][2 * rr] = bflo(uw[rr]); vn[tile][2 * rr + 1] = bfhi(uw[rr]); }
#pragma unroll
                for (int i = 0; i < 16; ++i) o[tile][i] = 0.f;
            }
#pragma unroll
            for (int ks = 0; ks < 8; ++ks)
#pragma unroll
                for (int tile = 0; tile < 2; ++tile) {
                    const bf16x8 af = *(const LAS bf16x8*)(fb + FR_NW + ((tile * 8 + ks) * 64 + lane) * 16), bq = *(const LAS bf16x8*)(fb + FR_QD + ((tile * 8 + ks) * 64 + lane) * 16);
                    vn[tile] = MFMA32(af, Sb[ks], vn[tile]); o[tile] = MFMA32(bq, Sb[ks], o[tile]); }
            bf16x8 vb[4];
#pragma unroll
            for (int tile = 0; tile < 2; ++tile) { vb[2 * tile] = pack_step(vn[tile], 0); vb[2 * tile + 1] = pack_step(vn[tile], 1); }
#pragma unroll
            for (int t = 0; t < 4; ++t)
#pragma unroll
                for (int i = 0; i < 16; ++i) S[t][i] *= gl;
#pragma unroll
            for (int ks = 0; ks < 4; ++ks) {
#pragma unroll
                for (int tile = 0; tile < 2; ++tile) { const bf16x8 af = *(const LAS bf16x8*)(fb + FR_QK + ((tile * 4 + ks) * 64 + lane) * 16); o[tile] = MFMA32(af, vb[ks], o[tile]); }
#pragma unroll
                for (int t = 0; t < 4; ++t) { const bf16x8 af = *(const LAS bf16x8*)(fb + FR_KD + ((t * 4 + ks) * 64 + lane) * 16); S[t] = MFMA32(af, vb[ks], S[t]); }
            }
#pragma unroll
            for (int tile = 0; tile < 2; ++tile)
#pragma unroll
                for (int rr = 0; rr < 8; ++rr) opk[tile * 8 + rr] = pk2(o[tile][2 * rr], o[tile][2 * rr + 1]);
        }
        WAIT_VM0(); RAW_BAR();
    }
    if (wid < 4) scan_store_o(OA + (size_t)127 * 64 * DM, opk, hh);
}

constexpr int AT_K = 0, AT_V = 73728;
DI float max3f(float a, float b, float c) { float r; asm("v_max3_f32 %0, %1, %2, %3" : "=v"(r) : "v"(a), "v"(b), "v"(c)); return r; }
constexpr int TK_STAGE = 122880, TK_NGU = 16384, TK_ITEMS = 16384 + 8192;
struct Trickle { int next, step, sa, boff; const float* wgu; const float* wd; };
DI void tk_read(LAS const unsigned char* buf, int wid, int lane, float (&f)[8]) {
    const int c = lane & 7, nn = lane >> 3;
    LAS const unsigned char* p = buf + (8 * c) * 256 + ((2 * wid + (nn >> 2) + 2 * c) & 15) * 16 + (nn & 3) * 4;
#pragma unroll
    for (int k = 0; k < 8; ++k) f[k] = *(const LAS float*)(p + k * 256);
}
DI float sat_fp8(float x) { return __builtin_amdgcn_fmed3f(x, -448.f, 448.f); }
DI unsigned pk4_fp8(float a, float b, float c, float d) { int p = __builtin_amdgcn_cvt_pk_fp8_f32(sat_fp8(a), sat_fp8(b), 0, false); p = __builtin_amdgcn_cvt_pk_fp8_f32(sat_fp8(c), sat_fp8(d), p, true); return (unsigned)p; }
DI void tk_store(const Args& a, int it, int wid, int lane, const float (&f)[8]) {
    const int c = lane & 7, nn = lane >> 3;
    unsigned char* WT;
    if (it < TK_NGU) { const int e = it >> 9, ri = it & 511, kb = ri >> 5, nb = ri & 31; WT = a.ws + WS_WGU + ((size_t)e * 2048 * 1024 + (size_t)(64 * nb) * 1024 + 64 * kb); }
    else { const int r = it - TK_NGU, e = r >> 8, ri = r & 255, kb = ri >> 4, nb = ri & 15; WT = a.ws + WS_WD + ((size_t)e * 1024 * 1024 + (size_t)(64 * nb) * 1024 + 64 * kb); }
    unsigned voff = (unsigned)((8 * wid + nn) * 1024 + 8 * c); asm volatile("" : "+v"(voff));
    constexpr float sc = (float)(1 << pg8::F8_WSHIFT);
    u32x2 w; w.x = pk4_fp8(f[0] * sc, f[1] * sc, f[2] * sc, f[3] * sc); w.y = pk4_fp8(f[4] * sc, f[5] * sc, f[6] * sc, f[7] * sc);
    __builtin_nontemporal_store(w, (u32x2*)(WT + voff));
}
DI void tk_stage(const Trickle& tk, LAS unsigned char* buf, int it, int wid, int lane) {
    const unsigned char* W; int sh;
    if (it < TK_NGU) { const int e = it >> 9, ri = it & 511, kb = ri >> 5, nb = ri & 31; sh = 13; W = (const unsigned char*)(tk.wgu + (size_t)e * 1024 * 2048 + (size_t)(64 * kb) * 2048 + 64 * nb); }
    else { const int r = it - TK_NGU, e = r >> 8, ri = r & 255, kb = ri >> 4, nb = ri & 15; sh = 12; W = (const unsigned char*)(tk.wd + (size_t)e * 1024 * 1024 + (size_t)(64 * kb) * 1024 + 64 * nb); }
    const unsigned voff = ((unsigned)(8 * wid + (lane >> 4)) << sh) + (unsigned)(((lane - 2 * wid) & 15) * 16);
    GLDS16_NT(W + voff, buf + wid * 2048); GLDS16_NT(W + ((size_t)4 << sh) + voff, buf + wid * 2048 + 1024);
}
DI int tk_step(LAS unsigned char* lds, Trickle& tk, int wid, int lane, float (&f)[8]) {
    const int cv = tk.sa;
    if (cv >= 0) tk_read(lds + TK_STAGE + (tk.boff ^ 16384), wid, lane, f);
    if (tk.next < TK_ITEMS) { tk_stage(tk, lds + TK_STAGE + tk.boff, tk.next, wid, lane); tk.sa = tk.next; tk.next += tk.step; } else tk.sa = -1;
    tk.boff ^= 16384;
    return cv;
}
DI void tk_drain(const Args& a, LAS unsigned char* lds, Trickle& tk, int wid, int lane) {
    for (;;) {
        float f[8] = {0.f, 0.f, 0.f, 0.f, 0.f, 0.f, 0.f, 0.f};
        if (tk.sa >= 0) { tk_read(lds + TK_STAGE + (tk.boff ^ 16384), wid, lane, f); tk_store(a, tk.sa, wid, lane, f); }
        if (tk.next >= TK_ITEMS) break;
        tk_stage(tk, lds + TK_STAGE + tk.boff, tk.next, wid, lane); tk.sa = tk.next; tk.next += tk.step; tk.boff ^= 16384;
        WAIT_VM0(); __syncthreads();
    }
}
#define MFMA16(a, b, c) __builtin_amdgcn_mfma_f32_16x16x32_bf16((a), (b), (c), 0, 0, 0)
DI void attn_unit(const Args& a, LAS unsigned char* lds, int bh, int qb, Trickle& tk) {
    const int tid = tidx(), lane = tid & 63, wid = __builtin_amdgcn_readfirstlane(tid >> 6), r = lane & 15, g = lane >> 4;
    bh = __builtin_amdgcn_readfirstlane(bh); qb = __builtin_amdgcn_readfirstlane(qb);
    const int b = bh >> 3, h = bh & 7;
    const bf16_t* Qg = (const bf16_t*)(a.ws + WS_Q); const bf16_t* Kg = (const bf16_t*)(a.ws + WS_K); const bf16_t* Vg = (const bf16_t*)(a.ws + WS_V); bf16_t* OB = (bf16_t*)(a.ws + WS_OB);
    const size_t rowb = (size_t)b * SEQ; const int q0 = qb * 256;
    const int NT = 4 * qb + 4, cw = 4 * qb + (wid >> 1);
    const unsigned char* ksrc = (const unsigned char*)(Kg + (size_t)bh * 128 * 12288);
    const unsigned char* vsrc = (const unsigned char*)(Vg + (size_t)bh * 128 * 8192);
    const unsigned dmo = (unsigned)(wid * 1024 + lane * 16);
#define ATT_DMA(t, slot) do {        \
        _Pragma("unroll") for (int i_ = 0; i_ < 3; ++i_) { unsigned d_ = dmo; unsigned po_ = 8192u * i_; asm volatile("" : "+v"(d_), "+s"(po_)); GLDS16(ksrc + ((size_t)(t) * 24576 + po_) + d_, lds + AT_K + (slot) * 24576 + (wid + 8 * i_) * 1024); } \
        _Pragma("unroll") for (int i_ = 0; i_ < 2; ++i_) { unsigned d_ = dmo; unsigned po_ = 8192u * i_; asm volatile("" : "+v"(d_), "+s"(po_)); GLDS16(vsrc + ((size_t)(t) * 16384 + po_) + d_, lds + AT_V + (slot) * 16384 + (wid + 8 * i_) * 1024); } } while (0)
    ATT_DMA(0, 0);
    if (NT > 1) ATT_DMA(1, 1);
    bf16x8 qf[2][6];
    { const bf16_t* qp = Qg + (rowb + q0 + 32 * wid + r) * 1536 + h * 192 + 8 * g;
#pragma unroll
      for (int qq = 0; qq < 2; ++qq)
#pragma unroll
          for (int ks = 0; ks < 6; ++ks) qf[qq][ks] = *(const bf16x8*)(qp + (size_t)qq * 16 * 1536 + 32 * ks);
#pragma unroll
      for (int qq = 0; qq < 2; ++qq)
#pragma unroll
          for (int ks = 0; ks < 6; ++ks) asm volatile("" : "+v"(qf[qq][ks])); }
    f32x4 o[2][8];
#pragma unroll
    for (int qq = 0; qq < 2; ++qq)
#pragma unroll
        for (int d = 0; d < 8; ++d) o[qq][d] = (f32x4){0.f, 0.f, 0.f, 0.f};
    float mrun[2] = {0.f, 0.f}, lrun[2] = {0.f, 0.f};
    const unsigned krd = (unsigned)(g * 1024 + r * 16);
    const unsigned vrd = (unsigned)((4 * g + (r >> 2)) * 32 + (r & 3) * 8);
    if (NT > 1) asm volatile("s_waitcnt vmcnt(5)" ::: "memory"); else WAIT_VM0();
    RAW_BAR();
    int s0 = 0, s1 = 1, s2 = 2;
    for (int t = 0; t < NT; ++t) {
        bf16x8 kf[3][4];
        LAS const unsigned char* kb = lds + AT_K + s0 * 24576 + krd;
#define ATT_KLD(ks_) do { _Pragma("unroll") for (int kvb = 0; kvb < 4; ++kvb) kf[(ks_) % 3][kvb] = *(const LAS bf16x8*)(kb + (ks_) * 4096 + kvb * 256); } while (0)
        if (t <= cw) { ATT_KLD(0); ATT_KLD(1); }
        __builtin_amdgcn_sched_barrier(0);
        float tf[8] = {0.f, 0.f, 0.f, 0.f, 0.f, 0.f, 0.f, 0.f};
        const int tcv = tk_step(lds, tk, wid, lane, tf);
        if (t + 2 < NT) ATT_DMA(t + 2, s2);
        asm volatile("" : "+v"(tf[0]), "+v"(tf[1]), "+v"(tf[2]), "+v"(tf[3]), "+v"(tf[4]), "+v"(tf[5]), "+v"(tf[6]), "+v"(tf[7]));
        if (tcv >= 0) tk_store(a, tcv, wid, lane, tf);
        if (t <= cw) {
            LAS const unsigned char* vbuf = lds + AT_V + s0 * 16384 + vrd;
            f32x4 sT[4][2];
#pragma unroll
            for (int kvb = 0; kvb < 4; ++kvb)
#pragma unroll
                for (int qq = 0; qq < 2; ++qq) sT[kvb][qq] = (f32x4){-mrun[qq], -mrun[qq], -mrun[qq], -mrun[qq]};
            {
                __builtin_amdgcn_sched_barrier(0);
#pragma unroll
                for (int ks = 0; ks < 6; ++ks) {
                    if (ks + 2 < 6) ATT_KLD(ks + 2);
#pragma unroll
                    for (int kvb = 0; kvb < 4; ++kvb)
#pragma unroll
                        for (int qq = 0; qq < 2; ++qq) sT[kvb][qq] = MFMA16(kf[ks % 3][kvb], qf[qq][ks], sT[kvb][qq]);
                }
#pragma unroll
                for (int i = 0; i < 4; ++i) { __builtin_amdgcn_sched_group_barrier(0x100, 4, 0); __builtin_amdgcn_sched_group_barrier(0x008, 8, 0); }
#pragma unroll
                for (int i = 0; i < 2; ++i) __builtin_amdgcn_sched_group_barrier(0x008, 8, 0);
                __builtin_amdgcn_sched_barrier(0);
            }
            s16x4 vlo[4], vhi[4];
            const unsigned va = (unsigned)(size_t)vbuf;
#define ATT_VLD(i_) do { \
                    asm volatile("ds_read_b64_tr_b16 %0, %1 offset:%2" : "=v"(vlo[(i_) & 3]) : "v"(va), "n"(((i_) & 7) * 2048 + ((i_) >> 3) * 1024) : "memory"); \
                    asm volatile("ds_read_b64_tr_b16 %0, %1 offset:%2" : "=v"(vhi[(i_) & 3]) : "v"(va), "n"(((i_) & 7) * 2048 + ((i_) >> 3) * 1024 + 512) : "memory"); } while (0)
            ATT_VLD(0); ATT_VLD(1); ATT_VLD(2);
            asm volatile("s_nop 15\n\ts_nop 7" : "+v"(sT[0][0]), "+v"(sT[0][1]), "+v"(sT[1][0]), "+v"(sT[1][1]), "+v"(sT[2][0]), "+v"(sT[2][1]), "+v"(sT[3][0]), "+v"(sT[3][1]));
            float mx[2];
#pragma unroll
            for (int qq = 0; qq < 2; ++qq) {
                float m0 = max3f(sT[0][qq][0], sT[0][qq][1], sT[0][qq][2]), m1 = max3f(sT[0][qq][3], sT[1][qq][0], sT[1][qq][1]);
                m0 = max3f(m0, sT[1][qq][2], sT[1][qq][3]); m1 = max3f(m1, sT[2][qq][0], sT[2][qq][1]);
                m0 = max3f(m0, sT[2][qq][2], sT[2][qq][3]); m1 = max3f(m1, sT[3][qq][0], sT[3][qq][1]);
                m0 = max3f(m0, sT[3][qq][2], sT[3][qq][3]); m0 = fmaxf(m0, m1);
                { auto r16 = __builtin_amdgcn_permlane16_swap(__float_as_uint(m0), __float_as_uint(m0), false, false); m0 = fmaxf(__uint_as_float(r16[0]), __uint_as_float(r16[1])); }
                { auto r32 = __builtin_amdgcn_permlane32_swap(__float_as_uint(m0), __float_as_uint(m0), false, false); m0 = fmaxf(__uint_as_float(r32[0]), __uint_as_float(r32[1])); }
                mx[qq] = m0; }
            if (t == 0 || __any(mx[0] > 8.f || mx[1] > 8.f)) {
#pragma unroll
                for (int qq = 0; qq < 2; ++qq) {
                    const float dl = (t == 0) ? mx[qq] : fmaxf(mx[qq], 0.f);
                    mrun[qq] += dl;
#pragma unroll
                    for (int kvb = 0; kvb < 4; ++kvb) sT[kvb][qq] = sT[kvb][qq] - dl;
                    if (t != 0) {
                        const float alpha = __builtin_amdgcn_exp2f(-dl);
                        lrun[qq] *= alpha;
#pragma unroll
                        for (int i = 0; i < 4; ++i) { const float ar = __shfl(alpha, 4 * g + i);
#pragma unroll
                            for (int d = 0; d < 8; ++d) o[qq][d][i] *= ar; }
                    }
                }
            }
            bf16x8 pa[2][2];
#pragma unroll
            for (int qq = 0; qq < 2; ++qq) {
                float ps0 = 0.f, ps1 = 0.f;
#pragma unroll
                for (int kvb = 0; kvb < 4; ++kvb) {
#pragma unroll
                    for (int i = 0; i < 4; ++i) sT[kvb][qq][i] = __builtin_amdgcn_exp2f(sT[kvb][qq][i]);
                    ps0 += sT[kvb][qq][0] + sT[kvb][qq][1]; ps1 += sT[kvb][qq][2] + sT[kvb][qq][3]; }
                lrun[qq] += ps0 + ps1;
#pragma unroll
                for (int s = 0; s < 2; ++s) pa[qq][s] = pack8(sT[2 * s][qq][0], sT[2 * s][qq][1], sT[2 * s][qq][2], sT[2 * s][qq][3], sT[2 * s + 1][qq][0], sT[2 * s + 1][qq][1], sT[2 * s + 1][qq][2], sT[2 * s + 1][qq][3]);
            }
            {
                __builtin_amdgcn_sched_barrier(0);
#pragma unroll
                for (int i = 0; i < 16; ++i) {
                    if (i + 3 < 16) ATT_VLD(i + 3);
                    if (i <= 12) asm volatile("s_waitcnt lgkmcnt(6)" : "+v"(vlo[i & 3]), "+v"(vhi[i & 3]));
                    else if (i == 13) asm volatile("s_waitcnt lgkmcnt(4)" : "+v"(vlo[i & 3]), "+v"(vhi[i & 3]));
                    else if (i == 14) asm volatile("s_waitcnt lgkmcnt(2)" : "+v"(vlo[i & 3]), "+v"(vhi[i & 3]));
                    else asm volatile("s_waitcnt lgkmcnt(0)" : "+v"(vlo[i & 3]), "+v"(vhi[i & 3]));
                    const s16x4 lo = vlo[i & 3], hi = vhi[i & 3];
                    const bf16x8 vf = {lo[0], lo[1], lo[2], lo[3], hi[0], hi[1], hi[2], hi[3]};
                    o[0][i & 7] = MFMA16(pa[0][i >> 3], vf, o[0][i & 7]); o[1][i & 7] = MFMA16(pa[1][i >> 3], vf, o[1][i & 7]);
                    __builtin_amdgcn_sched_barrier(0);
                }
#undef ATT_VLD
            }
        }
#undef ATT_KLD
        if (t + 2 < NT) asm volatile("s_waitcnt vmcnt(5)" ::: "memory"); else WAIT_VM0();
        RAW_BAR();
        { const int tmp = s0; s0 = s1; s1 = s2; s2 = tmp; }
    }
#undef ATT_DMA
    bf16_t* op = OB + (rowb + q0 + 32 * wid) * DM + h * 128 + r;
#pragma unroll
    for (int qq = 0; qq < 2; ++qq) {
        float lt = lrun[qq]; lt += __shfl_xor(lt, 16); lt += __shfl_xor(lt, 32);
        const float inv = 1.f / lt;
#pragma unroll
        for (int i = 0; i < 4; ++i) { const float ir = __shfl(inv, 4 * g + i);
#pragma unroll
            for (int d = 0; d < 8; ++d) op[(size_t)(16 * qq + 4 * g + i) * DM + 16 * d] = f2bf(o[qq][d][i] * ir); }
    }
}

DI void gated_norm_pass(const Args& a) {
    const int lane = tidx() & 63, gw = blockIdx.x * 8 + (tidx() >> 6), NGW = gridDim.x * 8;
    const bf16_t* OA = (const bf16_t*)(a.ws + WS_OA); const bf16_t* proj = (const bf16_t*)(a.ws + WS_PROJ); bf16_t* AA = (bf16_t*)(a.ws + WS_AA);
    float wv[16];
#pragma unroll
    for (int e = 0; e < 16; ++e) wv[e] = a.in[I_GNW][(16 * lane + e) & 127];
    for (int row = gw; row < T_TOK; row += NGW) {
        const u32x4 oa = __builtin_nontemporal_load((const u32x4*)(OA + (size_t)row * DM + 16 * lane)), ob = __builtin_nontemporal_load((const u32x4*)(OA + (size_t)row * DM + 16 * lane + 8));
        const u32x4 za = __builtin_nontemporal_load((const u32x4*)(proj + (size_t)row * NP + C_Z + 16 * lane)), zb = __builtin_nontemporal_load((const u32x4*)(proj + (size_t)row * NP + C_Z + 16 * lane + 8));
        const unsigned ow[8] = {oa.x, oa.y, oa.z, oa.w, ob.x, ob.y, ob.z, ob.w}, zw[8] = {za.x, za.y, za.z, za.w, zb.x, zb.y, zb.z, zb.w};
        float ov[16], zv[16]; float ss = 0.f;
#pragma unroll
        for (int q = 0; q < 8; ++q) { ov[2 * q] = bflo(ow[q]); ov[2 * q + 1] = bfhi(ow[q]); zv[2 * q] = bflo(zw[q]); zv[2 * q + 1] = bfhi(zw[q]); ss += ov[2 * q] * ov[2 * q] + ov[2 * q + 1] * ov[2 * q + 1]; }
        ss += __shfl_xor(ss, 1); ss += __shfl_xor(ss, 2); ss += __shfl_xor(ss, 4);
        const float rs = rsqrtf(ss * (1.f / 128.f) + EPS);
        unsigned w[8];
#pragma unroll
        for (int q = 0; q < 8; ++q) { const float z0 = zv[2 * q], z1 = zv[2 * q + 1]; w[q] = pk2(ov[2 * q] * rs * wv[2 * q] * (z0 * sigmoidf_(z0)), ov[2 * q + 1] * rs * wv[2 * q + 1] * (z1 * sigmoidf_(z1))); }
        const u32x4 wa = {w[0], w[1], w[2], w[3]}, wb = {w[4], w[5], w[6], w[7]};
        *(u32x4*)(AA + (size_t)row * DM + 16 * lane) = wa; *(u32x4*)(AA + (size_t)row * DM + 16 * lane + 8) = wb;
    }
}

constexpr int RT_P = 0, RT_SS = 67584, RT_RS = 69632, RT_HIST = 69888;
DI void router_pass(const Args& a, LAS unsigned char* lds) {
    const int tid = tidx(), lane = tid & 63, wave = __builtin_amdgcn_readfirstlane(tid >> 6), i = lane & 31, kk = lane >> 5;
    LAS float* P = (LAS float*)(lds + RT_P); LAS float* SS = (LAS float*)(lds + RT_SS); LAS float* RS = (LAS float*)(lds + RT_RS); LAS int* hist = (LAS int*)(lds + RT_HIST);
    const float* X1 = (const float*)(a.ws + WS_X1); bf16_t* H2 = (bf16_t*)(a.ws + WS_H2);
    int* TOPI = (int*)(a.ws + WS_TOPI); float* TOPW = (float*)(a.ws + WS_TOPW);
    const float* wffn = a.in[I_NFFN]; const float* br = a.in[I_BR];
    const int kbase = 128 * wave + 64 * kk;
    float bq[64];
    { const float* wr = a.in[I_WR] + (size_t)kbase * 32 + i;
#pragma unroll
      for (int m = 0; m < 64; ++m) bq[m] = wr[m * 32] * wffn[kbase + m]; }
    if (tid < 32) hist[tid] = 0;
    for (int wg = blockIdx.x; wg < T_TOK / 64; wg += gridDim.x) {
#pragma unroll
        for (int rb = 0; rb < 2; ++rb) {
            const float* xr = X1 + (size_t)(wg * 64 + 32 * rb + i) * DM + kbase;
            f32x4 xq[16];
#pragma unroll
            for (int q = 0; q < 16; ++q) xq[q] = *(const f32x4*)(xr + 4 * q);
            f32x16 acc;
#pragma unroll
            for (int r = 0; r < 16; ++r) acc[r] = 0.f;
            float ss = 0.f;
#pragma unroll
            for (int q = 0; q < 16; ++q)
#pragma unroll
                for (int c = 0; c < 4; ++c) { acc = __builtin_amdgcn_mfma_f32_32x32x2f32(xq[q][c], bq[4 * q + c], acc, 0, 0, 0); ss += xq[q][c] * xq[q][c]; }
            ss += __shfl_xor(ss, 32);
            if (kk == 0) SS[wave * 64 + 32 * rb + i] = ss;
#pragma unroll
            for (int r = 0; r < 16; ++r) P[((wave * 2 + rb) * 32 + crow(r, kk)) * 33 + i] = acc[r];
        }
        __syncthreads();
        if (tid < 64) {
            const int rb = tid >> 5, rr = tid & 31, row = wg * 64 + tid;
            float s = 0.f;
#pragma unroll
            for (int w2 = 0; w2 < 8; ++w2) s += SS[w2 * 64 + tid];
            const float rs = rsqrtf(s * (1.f / DM) + EPS);
            RS[tid] = rs;
            float lg[32];
#pragma unroll
            for (int e = 0; e < 32; ++e) { float v = 0.f;
#pragma unroll
                for (int w2 = 0; w2 < 8; ++w2) v += P[((w2 * 2 + rb) * 32 + rr) * 33 + e];
                lg[e] = v * rs + br[e]; }
            int ti[4]; float tv[4];
#pragma unroll
            for (int k = 0; k < 4; ++k) { float best = -INFINITY; int bi = 0;
#pragma unroll
                for (int e = 0; e < 32; ++e) { const bool taken = (k > 0 && ti[0] == e) || (k > 1 && ti[1] == e) || (k > 2 && ti[2] == e); if (!taken && lg[e] > best) { best = lg[e]; bi = e; } }
                ti[k] = bi; tv[k] = best; }
            const float e1 = __expf(tv[1] - tv[0]), e2 = __expf(tv[2] - tv[0]), e3 = __expf(tv[3] - tv[0]); const float inv = 1.f / (1.f + e1 + e2 + e3);
            *(i32x4*)(TOPI + (size_t)row * 4) = (i32x4){ti[0], ti[1], ti[2], ti[3]}; *(f32x4*)(TOPW + (size_t)row * 4) = (f32x4){inv, e1 * inv, e2 * inv, e3 * inv};
            atomicAdd((int*)&hist[ti[0]], 1); atomicAdd((int*)&hist[ti[1]], 1); atomicAdd((int*)&hist[ti[2]], 1); atomicAdd((int*)&hist[ti[3]], 1);
        }
        __syncthreads();
#pragma unroll 8
        for (int j = 0; j < 32; ++j) { const int flat = j * 512 + tid, r = flat >> 8, c4 = flat & 255;
            const f32x4 xv = *(const f32x4*)(X1 + (size_t)(wg * 64 + r) * DM + 4 * c4), wn = *(const f32x4*)(wffn + 4 * c4); const float rs = RS[r];
            constexpr float sc = (float)(1 << pg8::F8_ASHIFT);
            *(unsigned*)((unsigned char*)H2 + (size_t)(wg * 64 + r) * DM + 4 * c4) = pk4_fp8(xv[0] * wn[0] * rs * sc, xv[1] * wn[1] * rs * sc, xv[2] * wn[2] * rs * sc, xv[3] * wn[3] * rs * sc); }
        if (tid < 32) { ((int*)(a.ws + WS_CNT))[wg * 32 + tid] = hist[tid]; hist[tid] = 0; }
        __syncthreads();
    }
}

DI void slot_pass(const Args& a, LAS unsigned char* lds) {
    const int tid = tidx(), lane = tid & 63, wave = tid >> 6;
    LAS int* ptot = (LAS int*)lds;
    LAS int* ppre = ptot + 512;
    LAS int* tot = ppre + 512;
    LAS int* pre = tot + 32;
    LAS int* pstart = pre + 32;
    LAS int* ltopi = pstart + 64;
    LAS int* lslot = ltopi + 256;
    const int* CNT = (const int*)(a.ws + WS_CNT); const int* TOPI = (const int*)(a.ws + WS_TOPI); int* TOKSLOT = (int*)(a.ws + WS_TOKSLOT);
    int* TILEE = (int*)(a.ws + WS_TILEE);
    int* SLOTTOK = (int*)(a.ws + WS_SLOTTOK);
    for (int wg = blockIdx.x; wg < T_TOK / 64; wg += gridDim.x) {
        { const int e = tid & 31, part = tid >> 5; int t = 0, p = 0;
          for (int q = 0; q < 16; ++q) { const int w2 = part * 16 + q; const int c = CNT[w2 * 32 + e]; t += c; if (w2 < wg) p += c; }
          ptot[part * 32 + e] = t; ppre[part * 32 + e] = p; }
        if (tid < 256) ltopi[tid] = TOPI[(size_t)wg * 256 + tid];
        __syncthreads();
        if (tid < 32) { int t = 0, p = 0; for (int q = 0; q < 16; ++q) { t += ptot[q * 32 + tid]; p += ppre[q * 32 + tid]; } tot[tid] = t; pre[tid] = p; }
        __syncthreads();
        if (tid == 0) { int s = 0; for (int e = 0; e < 32; ++e) { pstart[e] = s; s += ((tot[e] + 255) >> 8) << 8; } pstart[32] = s; }
        __syncthreads();
        LAS int* bcnt = lslot + 256;
        int my_e = 0, my_rank = 0;
        if (tid < 256) { my_e = ltopi[tid]; const unsigned long long lt = (1ull << lane) - 1ull;
#pragma unroll 4
            for (int e = 0; e < 32; ++e) { const unsigned long long mk = __ballot(my_e == e); if (my_e == e) my_rank = __popcll(mk & lt); if (lane == 0) bcnt[wave * 32 + e] = __popcll(mk); } }
        __syncthreads();
        if (tid < 256) { int base = pstart[my_e] + pre[my_e]; for (int w2 = 0; w2 < wave; ++w2) base += bcnt[w2 * 32 + my_e]; lslot[tid] = base + my_rank; }
        __syncthreads();
        if (tid < 256) { TOKSLOT[(size_t)wg * 256 + tid] = lslot[tid]; SLOTTOK[lslot[tid]] = wg * 64 + (tid >> 2); }
        if (wg == 0) { const int ntile = pstart[32] >> 8; if (tid == 0) TILEE[511] = ntile;
            for (int t = tid; t < ntile; t += 512) { int e = 0; for (int q = 1; q < 32; ++q) if (t * 256 >= pstart[q]) e = q; TILEE[t] = e; } }
        if (wg == 0) for (int idx = tid; idx < 32 * 256; idx += 512) { const int e = idx >> 8, sl = pstart[e] + tot[e] + (idx & 255); if (sl < pstart[e + 1]) SLOTTOK[sl] = 0; }
        __syncthreads();
    }
}

DI void final_pass(const Args& a) {
    const int lane = tidx() & 63, gw = blockIdx.x * 8 + (tidx() >> 6), NGW = gridDim.x * 8;
    const float* X1 = (const float*)(a.ws + WS_X1); const bf16_t* YS = (const bf16_t*)(a.ws + WS_YS);
    const int* TOKSLOT = (const int*)(a.ws + WS_TOKSLOT); const float* TOPW = (const float*)(a.ws + WS_TOPW);
    f32x4 wv[4];
#pragma unroll
    for (int j = 0; j < 4; ++j) wv[j] = *(const f32x4*)(a.in[I_NFIN] + 256 * j + 4 * lane);
    for (int row = gw; row < T_TOK; row += NGW) {
        f32x4 v[4];
#pragma unroll
        for (int j = 0; j < 4; ++j) v[j] = __builtin_nontemporal_load((const f32x4*)(X1 + (size_t)row * DM + 256 * j + 4 * lane));
#pragma unroll
        for (int k = 0; k < 4; ++k) { const int slot = TOKSLOT[(size_t)row * 4 + k]; const float w = TOPW[(size_t)row * 4 + k];
            const float w8 = w * (1.f / (float)(1 << pg8::F8_YSHIFT));
#pragma unroll
            for (int j = 0; j < 4; ++j) { const unsigned y = __builtin_nontemporal_load((const unsigned*)((const unsigned char*)YS + (size_t)slot * DM + 256 * j + 4 * lane));
                const f32x2 lo = __builtin_amdgcn_cvt_pk_f32_fp8((int)y, false), hi = __builtin_amdgcn_cvt_pk_f32_fp8((int)y, true);
                v[j][0] += w8 * lo[0]; v[j][1] += w8 * lo[1]; v[j][2] += w8 * hi[0]; v[j][3] += w8 * hi[1]; } }
        float s = 0.f;
#pragma unroll
        for (int j = 0; j < 4; ++j) s += (v[j][0] * v[j][0] + v[j][1] * v[j][1]) + (v[j][2] * v[j][2] + v[j][3] * v[j][3]);
        const float rs = rsqrtf(wave_sum(s) * (1.f / DM) + EPS);
#pragma unroll
        for (int j = 0; j < 4; ++j) __builtin_nontemporal_store(v[j] * rs * wv[j], (f32x4*)(a.out + (size_t)row * DM + 256 * j + 4 * lane));
    }
}


#define XB_TMO      128
#define XB_XCNT(j)  (256  + 64 * (j))
#define XB_XSUB(j)  (1280 + 64 * (j))
#define XB_XGEN(j)  (2304 + 64 * (j))
#define XB_TOP      3328
#define XB_TOPGEN   3392
#define XCD_BAR_WORDS 3456
#define XB_SPIN_CAP (1u << 20)
constexpr int CW_BAR = 4096;
constexpr int LDS_MISC = 162816;
DI unsigned xb_ld(unsigned* p)              { return __hip_atomic_load(p, __ATOMIC_RELAXED, __HIP_MEMORY_SCOPE_AGENT); }
DI unsigned xb_add(unsigned* p, unsigned v) { return __hip_atomic_fetch_add(p, v, __ATOMIC_RELAXED, __HIP_MEMORY_SCOPE_AGENT); }
DI unsigned xb_xcc_id() { return (unsigned)__builtin_amdgcn_s_getreg((3 << 11) | 20) & 0xFu; }
#define XB_SPIN(cond, bar) do { unsigned _sp = 0; while (cond) { __builtin_amdgcn_s_sleep(1); \
    if ((++_sp & 255u) == 0u) { if (xb_ld(&(bar)[XB_TMO])) break; if (_sp > XB_SPIN_CAP) { atomicAdd(&(bar)[XB_TMO], 1u); break; } } } } while (0)
struct XcdBarrier { unsigned* bar; unsigned x; volatile LAS unsigned* st; };
DI XcdBarrier xcd_barrier_post(unsigned* bar, volatile LAS unsigned* st) {
    XcdBarrier b; b.bar = bar; b.x = xb_xcc_id(); b.st = st;
    if (threadIdx_x_raw() == 0) (void)xb_add(&bar[XB_XCNT(b.x)], 1u);
    return b;
}
DI void xcd_barrier_complete(unsigned* bar, unsigned x, unsigned& nloc, unsigned& nx) {
    const unsigned G = gridDim.x * gridDim.y * gridDim.z;
    unsigned sum, cnt, mine, sp = 0u;
    for (;;) {
        sum = 0u; cnt = 0u; mine = 0u;
#pragma unroll
        for (unsigned j = 0; j < 16; ++j) { const unsigned c = xb_ld(&bar[XB_XCNT(j)]); sum += c; cnt += (c > 0u) ? 1u : 0u; mine = (j == x) ? c : mine; }
        if (sum == G) break;
        __builtin_amdgcn_s_sleep(1);
        if ((++sp & 255u) == 0u) { if (xb_ld(&bar[XB_TMO])) break; if (sp > XB_SPIN_CAP) { atomicAdd(&bar[XB_TMO], 1u); break; } }
    }
    nloc = mine > 0u ? mine : 1u; nx = cnt > 0u ? cnt : 1u;
}
DI void xcd_barrier(const XcdBarrier& b) {
    asm volatile("s_waitcnt vmcnt(0)" ::: "memory");
    __syncthreads();
    if (threadIdx_x_raw() == 0) {
        unsigned* bar = b.bar;
        __builtin_amdgcn_s_waitcnt(0);
        unsigned nloc = b.st[0], nx = b.st[1];
        if (nloc == 0u) { xcd_barrier_complete(bar, b.x, nloc, nx); b.st[0] = nloc; b.st[1] = nx; }
        const unsigned old = xb_add(&bar[XB_XSUB(b.x)], 1u);
        const unsigned gen = old / nloc;
        if (old + 1u == (gen + 1u) * nloc) {
            __builtin_amdgcn_fence(__ATOMIC_RELEASE, "agent");
            asm volatile("s_waitcnt vmcnt(0)" ::: "memory");
            const unsigned og = xb_add(&bar[XB_TOP], 1u);
            const unsigned tg = og / nx;
            if (og + 1u == (tg + 1u) * nx) xb_add(&bar[XB_TOPGEN], 1u);
            else XB_SPIN(xb_ld(&bar[XB_TOPGEN]) == tg, bar);
            __builtin_amdgcn_fence(__ATOMIC_ACQUIRE, "agent");
            xb_add(&bar[XB_XGEN(b.x)], 1u);
            asm volatile("s_waitcnt vmcnt(0)" ::: "memory");
        } else {
            XB_SPIN(xb_ld(&bar[XB_XGEN(b.x)]) == gen, bar);
            __builtin_amdgcn_fence(__ATOMIC_ACQUIRE, "agent");
            asm volatile("s_waitcnt vmcnt(0)" ::: "memory");
        }
    }
    __syncthreads();
}

constexpr int NPH = 12;
#ifndef PROBE_REP
#define PROBE_REP {1,1,1,1,1,1,1,1,1,1,1,1}
#endif
constexpr int REP[NPH] = PROBE_REP;
template <bool COOP>
__global__ void __launch_bounds__(512, 2) mega(Args a_by_value) {
    const Args& a = *(const Args*)(const __attribute__((address_space(4))) Args*)__builtin_amdgcn_kernarg_segment_ptr();
    extern __shared__ __attribute__((aligned(16))) unsigned char lds_raw[];
    LAS unsigned char* lds = (LAS unsigned char*)lds_raw;
    const int lo = a.ph_lo, hi = a.ph_hi;
    const int G = gridDim.x, bx = blockIdx.x;
    unsigned char* ws = a.ws;
#define IN(k) (lo <= (k) && (k) < hi)
    XcdBarrier gbar; gbar.bar = (unsigned*)(ws + WS_CTL) + CW_BAR; gbar.x = 0; gbar.st = (volatile LAS unsigned*)(lds + LDS_MISC);
    if (COOP) { if (tidx() < 2) ((LAS unsigned*)(lds + LDS_MISC))[tidx()] = 0u; __syncthreads(); gbar = xcd_barrier_post((unsigned*)(ws + WS_CTL) + CW_BAR, (volatile LAS unsigned*)(lds + LDS_MISC)); }
#define SYNC(k) do { if (COOP && IN(k) && IN((k) + 1)) { xcd_barrier(gbar); } } while (0)
    if (IN(0)) for (int rep_ = 0; rep_ < REP[0]; ++rep_) { phase_prologue(a, lds); }
    SYNC(0);
    if (IN(1)) for (int rep_ = 0; rep_ < REP[1]; ++rep_) {
        pg8::DenseSched S{(const char*)(ws + WS_XN), (const char*)(ws + WS_WIN), (size_t)256 * DM * 2, (size_t)256 * DM * 2, T_TOK / 256, NP / 256, G, bx};
        pg8::EpiProj E{(bf16_t*)(ws + WS_PROJ), (float*)(ws + WS_SSQQ), (float*)(ws + WS_SSQKV)};
        pg8::gemm_phase(lds, DM, DM, DM, S, E);
    }
    SYNC(1);
    if (IN(2)) for (int rep_ = 0; rep_ < REP[2]; ++rep_) {
#ifndef PROBE_PREP_REP
#define PROBE_PREP_REP 1
#endif
        for (int pr_ = 0; pr_ < PROBE_PREP_REP; ++pr_) {
            u32x4 xr[3][5];
            const bool wgm = (2048 % G) == 0; const int per = wgm ? 2048 / G : 0;
            const int u0 = wgm ? bx * per : bx, ustep = wgm ? 1 : G, uend = wgm ? (bx + 1) * per : 2048;
            if (u0 < uend) gdn_prep_load(a, u0 >> 7, u0 & 127, tidx(), xr);
            int hprev = -1;
            for (int u = u0; u < uend; u += ustep) { const int un = u + ustep; const int hcur = (u >> 7) & 7;
                gdn_prep_unit(a, lds, u >> 7, u & 127, xr, un < uend ? (un >> 7) : -1, un & 127, hcur != hprev); hprev = hcur; }
            __syncthreads();
        }
#ifndef PROBE_P2G_REP
#define PROBE_P2G_REP 1
#endif
        for (int pg_ = 0; pg_ < PROBE_P2G_REP; ++pg_) {
        krope_pass(a);
        { pg8::QKVSched S{(const char*)(ws + WS_PROJ) + C_CQ * 2, (const char*)(ws + WS_WQB), (const char*)(ws + WS_PROJ) + C_CKV * 2, (const char*)(ws + WS_WKVB), G, bx};
          pg8::EpiQKV E{pg8::EpiQ{(bf16_t*)(ws + WS_Q), (const float*)(ws + WS_SSQQ), (const f32x2*)(ws + WS_ROPE)}, pg8::EpiKV{(bf16_t*)(ws + WS_K), (bf16_t*)(ws + WS_V), (const float*)(ws + WS_SSQKV)}};
          pg8::gemm_phase(lds, NP, 512, 512, S, E); }
        }
    }
    SYNC(2);
    if (IN(3)) for (int rep_ = 0; rep_ < REP[3]; ++rep_) {
#ifndef PROBE_SCAN_REP
#define PROBE_SCAN_REP 1
#endif
        for (int sr_ = 0; sr_ < PROBE_SCAN_REP; ++sr_)
        if (bx < 16) gdn_scan_wg(a, lds, bx);
        __syncthreads();
        unsigned* ctr = (unsigned*)(ws + WS_CTL) + 64 * rep_;
        LAS int* su = (LAS int*)(lds + LDS_MISC + 64);
        Trickle tk; { const int nsc = G > 16 ? 16 : 0; tk.step = G - nsc; tk.next = bx >= nsc ? bx - nsc : TK_ITEMS; tk.sa = -1; tk.boff = 0; tk.wgu = a.in[I_WGU]; tk.wd = a.in[I_WD]; }
        for (;;) {
            if (tidx() == 0) su[0] = (int)atomicAdd(ctr, 1u);
            __syncthreads();
            const int u = su[0];
            __syncthreads();
            if (u >= 512) break;
            attn_unit(a, lds, u & 15, 31 - (u >> 4), tk);
        }
        tk_drain(a, lds, tk, __builtin_amdgcn_readfirstlane(tidx() >> 6), tidx() & 63);
    }
    SYNC(3);
    if (IN(4)) for (int rep_ = 0; rep_ < REP[4]; ++rep_) { gated_norm_pass(a); }
    SYNC(4);
    if (IN(5)) for (int rep_ = 0; rep_ < REP[5]; ++rep_) {
        { pg8::PairSched S{(const char*)(ws + WS_AA), (const char*)(ws + WS_WGDNO), (const char*)(ws + WS_OB), (const char*)(ws + WS_WMLAO), (size_t)256 * DM * 2, (size_t)256 * DM * 2, T_TOK / 256, DM / 256, G, bx};
          pg8::EpiMerge E{(bf16_t*)(ws + WS_MG), (const bf16_t*)(ws + WS_PROJ)};
          pg8::gemm_phase(lds, DM, DM, DM, S, E); }
    }
    SYNC(5);
    if (IN(6)) for (int rep_ = 0; rep_ < REP[6]; ++rep_) {
        pg8::DenseSched S{(const char*)(ws + WS_MG), (const char*)(ws + WS_WOUT), (size_t)256 * DM * 2, (size_t)256 * DM * 2, T_TOK / 256, DM / 256, G, bx};
        pg8::EpiRes E{a.in[I_X], (float*)(ws + WS_X1)};
        pg8::gemm_phase(lds, DM, DM, DM, S, E);
    }
    SYNC(6);
    if (IN(7)) for (int rep_ = 0; rep_ < REP[7]; ++rep_) { router_pass(a, lds); }
    SYNC(7);
    if (IN(8)) for (int rep_ = 0; rep_ < REP[8]; ++rep_) { slot_pass(a, lds); }
    SYNC(8);
    if (IN(9)) for (int rep_ = 0; rep_ < REP[9]; ++rep_) {
        const int* TILEE = (const int*)(ws + WS_TILEE);
        pg8::MoeSched S{(const char*)(ws + WS_H2), (const char*)(ws + WS_WGU), (size_t)0, (size_t)256 * DM, (size_t)2048 * 1024, TILEE, TILEE[511], 8, G, bx};
        pg8::EpiGU E{(bf16_t*)(ws + WS_ACT), a.in[I_BGU]};
        LAS int* tokmap = (LAS int*)(lds + 131072);
        { const int* SLOTTOK = (const int*)(ws + WS_SLOTTOK); pg8::Unit uu;
          for (int i = 0; i < 14 && S.next(i, uu); ++i) if (tidx() < 256) tokmap[i * 256 + tidx()] = SLOTTOK[uu.pm * 256 + tidx()];
          __syncthreads(); }
        pg8::gemm_phase<pg8::EpiGU, pg8::MoeSched, true, true>(lds, DM / 2, DM / 2, DM / 2, S, E, tokmap);
    }
    SYNC(9);
    if (IN(10)) for (int rep_ = 0; rep_ < REP[10]; ++rep_) {
        const int* TILEE = (const int*)(ws + WS_TILEE);
        pg8::MoeSched S{(const char*)(ws + WS_ACT), (const char*)(ws + WS_WD), (size_t)256 * DM, (size_t)256 * DM, (size_t)1024 * 1024, TILEE, TILEE[511], 4, G, bx};
        pg8::EpiDown E{(bf16_t*)(ws + WS_YS), a.in[I_BD]};
        pg8::gemm_phase<pg8::EpiDown, pg8::MoeSched, false, true>(lds, DM / 2, DM / 2, DM / 2, S, E);
    }
    SYNC(10);
    if (IN(11)) for (int rep_ = 0; rep_ < REP[11]; ++rep_) { final_pass(a); }
#undef IN
#undef SYNC
}

#ifndef N_LAUNCH_MODE
#define N_LAUNCH_MODE 1
#endif
extern "C" void kernel_launch(void* const* d_in, const int* in_sizes, int n_in, void* d_out, int out_size, void* d_ws, size_t ws_size, hipStream_t stream) {
    static int grid = 0;
    if (grid == 0) {
        if (n_in != 22 || out_size != T_TOK * DM || ws_size < WS_END) { fprintf(stderr, "kernel_launch: unexpected shapes (n_in %d, out %d, ws %zu)\n", n_in, out_size, ws_size); grid = -1; return; }
        int dev = 0, cus = 0, per_cu = 0;
        hipGetDevice(&dev); hipDeviceGetAttribute(&cus, hipDeviceAttributeMultiprocessorCount, dev);
        hipFuncSetAttribute((const void*)mega<false>, hipFuncAttributeMaxDynamicSharedMemorySize, LDS_BYTES);
        hipFuncSetAttribute((const void*)mega<true>, hipFuncAttributeMaxDynamicSharedMemorySize, LDS_BYTES);
        hipOccupancyMaxActiveBlocksPerMultiprocessor(&per_cu, (const void*)mega<true>, 512, LDS_BYTES);
        (void)hipGetLastError();
        if (per_cu < 1) per_cu = 1;
        grid = cus;
        if (grid > 256) grid = 256;
    }
    if (grid < 0) return;
    hipMemsetAsync((char*)d_ws + WS_CTL, 0, CTL_BYTES, stream);
    Args a{};
    for (int i = 0; i < 22; ++i) a.in[i] = (const float*)d_in[i];
    a.out = (float*)d_out; a.ws = (unsigned char*)d_ws;
#if N_LAUNCH_MODE == 1
    a.ph_lo = 0; a.ph_hi = NPH;
    void* args[] = {&a};
    hipError_t e = hipLaunchCooperativeKernel((const void*)mega<true>, dim3(grid), dim3(512), args, LDS_BYTES, stream);
    if (e != hipSuccess) fprintf(stderr, "cooperative launch failed: %s (grid %d)\n", hipGetErrorString(e), grid);
#else
    for (int p = 0; p < NPH; ++p) { a.ph_lo = p; a.ph_hi = p + 1; hipLaunchKernelGGL(mega<false>, dim3(grid), dim3(512), LDS_BYTES, stream, a); }
#endif
}
```
